# Optimizing an MI355X kernel written in HIP

```python
import jax, jax.numpy as jnp
from jax import lax
import numpy as np

D_MODEL = 1024
BATCH = 16
SEQ = 2048
DEPTH = 1

CHUNK = 64
Q_BLOCK = 128
MLA_HEADS = 8
QK_NOPE_DIM = 64
QK_ROPE_DIM = 32
QK_HEAD_DIM = QK_NOPE_DIM + QK_ROPE_DIM
V_HEAD_DIM = 64
Q_LORA_RANK = 256
KV_LORA_RANK = 128
ROPE_THETA = 10000.0
CONV_WIDTH = D_MODEL // 2
CONV_KERNEL = 31
N_BRANCHES = 2
N_GROUPS = 4
EXPERTS_PER_GROUP = 8
N_EXPERTS = N_GROUPS * EXPERTS_PER_GROUP
TOP_K_IN_GROUP = 2
EXPERT_FF = 256
EPS = 1e-6

IN_SIZES = (Q_LORA_RANK, KV_LORA_RANK, QK_ROPE_DIM, 2 * CONV_WIDTH, N_BRANCHES * D_MODEL)
IN_COLS = sum(IN_SIZES)
IN_SPLITS = tuple(int(v) for v in np.cumsum(IN_SIZES)[:-1])

kernel_name = "hybrid_mla_conformer_hiermoe_block"


def rms_norm(x, g):
    xf = x.astype(jnp.float32)
    y = xf * lax.rsqrt(jnp.mean(xf * xf, axis=-1, keepdims=True) + EPS)
    return (y * g.astype(jnp.float32)).astype(x.dtype)


def layer_norm(x, g, b):
    xf = x.astype(jnp.float32)
    mu = jnp.mean(xf, axis=-1, keepdims=True)
    var = jnp.mean(jnp.square(xf - mu), axis=-1, keepdims=True)
    y = (xf - mu) * lax.rsqrt(var + EPS)
    return (y * g.astype(jnp.float32) + b.astype(jnp.float32)).astype(x.dtype)


def apply_rope(x, positions):
    half = QK_ROPE_DIM // 2
    inv_freq = ROPE_THETA ** (-jnp.arange(half, dtype=jnp.float32) / half)
    ang = positions.astype(jnp.float32)[..., None] * inv_freq
    cos = jnp.cos(ang)[:, :, None, :]
    sin = jnp.sin(ang)[:, :, None, :]
    xf = x.astype(jnp.float32)
    x1, x2 = xf[..., :half], xf[..., half:]
    out = jnp.concatenate([x1 * cos - x2 * sin, x2 * cos + x1 * sin], axis=-1)
    return out.astype(x.dtype)


def chunk_causal_attention(q, k, v):
    B, T, H, Dh = q.shape
    Dv = v.shape[-1]
    nb = T // Q_BLOCK
    qb = q.reshape(B, nb, Q_BLOCK, H, Dh).transpose(1, 0, 2, 3, 4)
    key_chunk = jnp.arange(T) // CHUNK
    scale = Dh ** -0.5

    def one_block(args):
        qi, bi = args
        s = jnp.einsum('bqhd,bkhd->bhqk', qi, k, preferred_element_type=jnp.float32) * scale
        q_chunk = (bi * Q_BLOCK + jnp.arange(Q_BLOCK)) // CHUNK
        mask = key_chunk[None, :] <= q_chunk[:, None]
        s = jnp.where(mask[None, None], s, -jnp.inf)
        p = jax.nn.softmax(s, axis=-1).astype(v.dtype)
        return jnp.einsum('bhqk,bkhd->bqhd', p, v)

    out = lax.map(one_block, (qb, jnp.arange(nb)))
    return out.transpose(1, 0, 2, 3, 4).reshape(B, T, H, Dv)


def causal_depthwise_conv(u, w, b):
    K, C = w.shape
    y = lax.conv_general_dilated(
        u, w[:, None, :].astype(u.dtype), window_strides=(1,), padding=[(K - 1, 0)],
        dimension_numbers=('NWC', 'WIO', 'NWC'), feature_group_count=C)
    return y + b.astype(u.dtype)


def hierarchical_moe(h, w_gr, b_gr, w_er, b_er, w_eg, w_eu, w_ed):
    B, T, D = h.shape
    n = h.reshape(B * T, D)
    group_logits = jnp.matmul(n, w_gr).astype(jnp.float32) + b_gr.astype(jnp.float32)
    group_prob = jax.nn.softmax(group_logits, axis=-1)
    g_idx = jnp.argmax(group_logits, axis=-1)
    g_p = jnp.take_along_axis(group_prob, g_idx[:, None], axis=-1)
    exp_logits = (jnp.matmul(n, w_er).astype(jnp.float32) + b_er.astype(jnp.float32))
    exp_logits = exp_logits.reshape(B * T, N_GROUPS, EXPERTS_PER_GROUP)
    sel = jnp.take_along_axis(exp_logits, g_idx[:, None, None], axis=1)[:, 0]
    within = jax.nn.softmax(sel, axis=-1)
    top_p, top_i = lax.top_k(within, TOP_K_IN_GROUP)
    top_p = top_p / jnp.sum(top_p, axis=-1, keepdims=True)
    expert_id = g_idx[:, None] * EXPERTS_PER_GROUP + top_i
    weights = g_p * top_p
    combine = jnp.sum(jax.nn.one_hot(expert_id, N_EXPERTS, dtype=jnp.float32) * weights[..., None], axis=1)
    combine = combine.reshape(B, T, N_EXPERTS).astype(h.dtype)

    def per_sequence(args):
        xb, cb = args
        a = jnp.einsum('td,edf->tef', xb, w_eg)
        u = jnp.einsum('td,edf->tef', xb, w_eu)
        mid = jax.nn.silu(a) * u * cb[..., None]
        return jnp.einsum('tef,efd->td', mid, w_ed)

    return lax.map(per_sequence, (h, combine))


def setup_inputs(seed: int = 0) -> dict:
    key = jax.random.key(seed)
    ks = jax.random.split(key, 24)
    f32 = jnp.float32
    L, D, H = DEPTH, D_MODEL, MLA_HEADS

    def nrm(k, shape, fan_in):
        return jax.random.normal(k, shape, f32) * (fan_in ** -0.5)

    def gain(k, shape):
        return 1.0 + 0.02 * jax.random.normal(k, shape, f32)

    def bias(k, shape, s=0.02):
        return s * jax.random.normal(k, shape, f32)

    x = jax.random.normal(ks[0], (BATCH, SEQ, D), f32)
    offset = jax.random.randint(ks[1], (BATCH, 1), 0, 4096, dtype=jnp.int32)
    positions = (offset + jnp.arange(SEQ, dtype=jnp.int32)[None, :]).astype(jnp.int32)
    return {
        "x": x,
        "positions": positions,
        "g_mix": gain(ks[2], (L, D)),
        "w_in": nrm(ks[3], (L, D, IN_COLS), D),
        "g_q_lora": gain(ks[4], (L, Q_LORA_RANK)),
        "w_uq": nrm(ks[5], (L, Q_LORA_RANK, H * QK_HEAD_DIM), Q_LORA_RANK),
        "g_kv_lora": gain(ks[6], (L, KV_LORA_RANK)),
        "w_ukv": nrm(ks[7], (L, KV_LORA_RANK, H * (QK_NOPE_DIM + V_HEAD_DIM)), KV_LORA_RANK),
        "g_qk_q": gain(ks[8], (L, QK_HEAD_DIM)),
        "g_qk_k": gain(ks[9], (L, QK_HEAD_DIM)),
        "w_o_mla": nrm(ks[10], (L, H * V_HEAD_DIM, D), H * V_HEAD_DIM),
        "w_dw": nrm(ks[11], (L, CONV_KERNEL, CONV_WIDTH), CONV_KERNEL),
        "b_dw": bias(ks[12], (L, CONV_WIDTH)),
        "g_conv_ln": gain(ks[13], (L, CONV_WIDTH)),
        "b_conv_ln": bias(ks[14], (L, CONV_WIDTH)),
        "w_conv_out": nrm(ks[15], (L, CONV_WIDTH, D), CONV_WIDTH),
        "b_gates": bias(ks[16], (L, N_BRANCHES * D)),
        "w_out": nrm(ks[17], (L, D, D), D),
        "g_ffn": gain(ks[18], (L, D)),
        "w_group_router": nrm(ks[19], (L, D, N_GROUPS), D),
        "b_group_router": bias(ks[20], (L, N_GROUPS), 0.01),
        "w_expert_router": nrm(ks[21], (L, D, N_EXPERTS), D),
        "b_expert_router": bias(ks[22], (L, N_EXPERTS), 0.01),
        "w_e_gate": nrm(jax.random.fold_in(ks[23], 0), (L, N_EXPERTS, D, EXPERT_FF), D),
        "w_e_up": nrm(jax.random.fold_in(ks[23], 1), (L, N_EXPERTS, D, EXPERT_FF), D),
        "w_e_down": nrm(jax.random.fold_in(ks[23], 2), (L, N_EXPERTS, EXPERT_FF, D), EXPERT_FF),
    }


def reference(x, positions, g_mix, w_in, g_q_lora, w_uq, g_kv_lora, w_ukv, g_qk_q, g_qk_k,
              w_o_mla, w_dw, b_dw, g_conv_ln, b_conv_ln, w_conv_out, b_gates, w_out,
              g_ffn, w_group_router, b_group_router, w_expert_router, b_expert_router,
              w_e_gate, w_e_up, w_e_down):
    B, T, D = x.shape
    H = MLA_HEADS
    for l in range(DEPTH):
        h = rms_norm(x, g_mix[l])
        proj = jnp.matmul(h, w_in[l])
        q_down, kv_down, k_rope, conv_in, gate_logits = jnp.split(proj, IN_SPLITS, axis=-1)

        q = jnp.matmul(rms_norm(q_down, g_q_lora[l]), w_uq[l]).reshape(B, T, H, QK_HEAD_DIM)
        kv = jnp.matmul(rms_norm(kv_down, g_kv_lora[l]), w_ukv[l]).reshape(B, T, H, QK_NOPE_DIM + V_HEAD_DIM)
        k_nope, v = kv[..., :QK_NOPE_DIM], kv[..., QK_NOPE_DIM:]
        k_r = jnp.broadcast_to(k_rope[:, :, None, :], (B, T, H, QK_ROPE_DIM))
        k = jnp.concatenate([k_nope, k_r], axis=-1)
        q = rms_norm(q, g_qk_q[l])
        k = rms_norm(k, g_qk_k[l])
        q = jnp.concatenate([q[..., :QK_NOPE_DIM], apply_rope(q[..., QK_NOPE_DIM:], positions)], axis=-1)
        k = jnp.concatenate([k[..., :QK_NOPE_DIM], apply_rope(k[..., QK_NOPE_DIM:], positions)], axis=-1)
        attn = chunk_causal_attention(q, k, v).reshape(B, T, H * V_HEAD_DIM)
        y_a = jnp.matmul(attn, w_o_mla[l])

        c_val, c_gate = conv_in[..., :CONV_WIDTH], conv_in[..., CONV_WIDTH:]
        u = c_val * jax.nn.sigmoid(c_gate)
        u = causal_depthwise_conv(u, w_dw[l], b_dw[l])
        u = jax.nn.silu(layer_norm(u, g_conv_ln[l], b_conv_ln[l]))
        y_b = jnp.matmul(u, w_conv_out[l])

        gates = jax.nn.sigmoid(gate_logits + b_gates[l].astype(gate_logits.dtype))
        merged = gates[..., :D] * y_a + gates[..., D:] * y_b
        x = x + jnp.matmul(merged, w_out[l])

        h2 = rms_norm(x, g_ffn[l])
        x = x + hierarchical_moe(h2, w_group_router[l], b_group_router[l], w_expert_router[l],
                                 b_expert_router[l], w_e_gate[l], w_e_up[l], w_e_down[l])
    return x
```

```cpp
#include <hip/hip_runtime.h>
#include <hip/hip_cooperative_groups.h>
#include <cstdio>
#include <cstdint>

#define LAS __attribute__((address_space(3)))
typedef unsigned short bf16_t;
typedef short bf16x8 __attribute__((ext_vector_type(8)));
typedef short s16x4 __attribute__((ext_vector_type(4)));
typedef float f32x4 __attribute__((ext_vector_type(4)));
typedef float f32x16 __attribute__((ext_vector_type(16)));
typedef unsigned u32x4 __attribute__((ext_vector_type(4)));
typedef unsigned u32x2 __attribute__((ext_vector_type(2)));
typedef int v8i32 __attribute__((ext_vector_type(8)));

constexpr int NTOK = 32768, DM = 1024, SEQ = 2048, NBATCH = 16, NH = 8;
constexpr int INC = 3488, INP = 3584;
constexpr int QLR = 256, KVLR = 128, ROPE = 32, CONVW = 512, CONVK = 31;
constexpr int NEXP = 32, EFF = 256, CAP = NTOK;
constexpr float EPS = 1e-6f;
constexpr int NWAVES = 8, NTHR = 512;

constexpr size_t MiB = 1u << 20;
constexpr size_t WS_CTL = 0, CTL_ZERO_BYTES = 64 * 1024;
constexpr size_t WS_RSTD2 = 1 * MiB;
constexpr size_t WS_WRB = 1 * MiB + 256 * 1024;
constexpr size_t WS_WIN = 2 * MiB;
constexpr size_t WS_WQIMG = 9 * MiB;
constexpr size_t WS_WUKV = 9 * MiB + 512 * 1024;
constexpr size_t WS_RSTD1 = 1 * MiB + 512 * 1024;
constexpr size_t WS_WO = 10 * MiB;
constexpr size_t WS_WC = 11 * MiB;
constexpr size_t WS_WOUT = 12 * MiB;
constexpr size_t WS_WGU = 14 * MiB;
constexpr size_t WS_WD = 46 * MiB;
constexpr size_t WS_G = 64 * MiB;
constexpr size_t WS_XB8 = 128 * MiB;
constexpr size_t WS_A = 192 * MiB;
constexpr size_t WS_B = 256 * MiB;
constexpr size_t WS_C = 320 * MiB;
constexpr size_t WS_D = 384 * MiB;
constexpr size_t WS_E = 416 * MiB;
constexpr size_t WS_T = 464 * MiB;
constexpr size_t WS_END = 512 * MiB;
constexpr int CW_BAR = 1024;
constexpr int CW_CNT = 8192;
constexpr int CW_TCNT = 9216;

constexpr int RING_BYTES = 131072;
constexpr int LDS_BYTES = 147456;
constexpr int MISC_OFF = LDS_BYTES - 4096;
constexpr int LDS_BYTES_UNUSED_ = 0;

typedef float f32x2_t __attribute__((ext_vector_type(2))); typedef __bf16 bf16x2_t __attribute__((ext_vector_type(2)));
__device__ __forceinline__ unsigned cvt_pk_bf16(float lo, float hi) { f32x2_t v = {lo, hi}; bf16x2_t b = __builtin_convertvector(v, bf16x2_t); return __builtin_bit_cast(unsigned, b); }
__device__ __forceinline__ float bf_lo(unsigned w) { return __uint_as_float(w << 16); }
__device__ __forceinline__ float bf_hi(unsigned w) { return __uint_as_float(w & 0xffff0000u); }
__device__ __forceinline__ float bf2f(bf16_t b) { return __uint_as_float(((unsigned)b) << 16); }
__device__ __forceinline__ float sigmoidf_(float x) { return __builtin_amdgcn_rcpf(1.f + __builtin_amdgcn_exp2f(x * -1.4426950408889634f)); }
__device__ __forceinline__ float wave_sum(float v) {
#pragma unroll
    for (int o = 1; o < 64; o <<= 1) v += __shfl_xor(v, o);
    return v;
}
__device__ __forceinline__ void store8(bf16_t* p, f32x4 a, f32x4 b) {
    u32x4 w; w.x = cvt_pk_bf16(a[0], a[1]); w.y = cvt_pk_bf16(a[2], a[3]); w.z = cvt_pk_bf16(b[0], b[1]); w.w = cvt_pk_bf16(b[2], b[3]);
    *(u32x4*)p = w;
}
typedef _Float16 h16x2 __attribute__((ext_vector_type(2)));
__device__ __forceinline__ unsigned cvt_pk_f16(float a, float b) { const h16x2 h = {(_Float16)a, (_Float16)b}; return __builtin_bit_cast(unsigned, h); }
__device__ __forceinline__ void store8h(bf16_t* p, f32x4 a, f32x4 b) {
    u32x4 w; w.x = cvt_pk_f16(a[0], a[1]); w.y = cvt_pk_f16(a[2], a[3]); w.z = cvt_pk_f16(b[0], b[1]); w.w = cvt_pk_f16(b[2], b[3]);
    *(u32x4*)p = w;
}
__device__ __forceinline__ void load8(const bf16_t* p, f32x4& a, f32x4& b) {
    const u32x4 w = *(const u32x4*)p;
    a = (f32x4){bf_lo(w.x), bf_hi(w.x), bf_lo(w.y), bf_hi(w.y)}; b = (f32x4){bf_lo(w.z), bf_hi(w.z), bf_lo(w.w), bf_hi(w.w)};
}
__device__ __forceinline__ int lane_id_fresh() { unsigned z = 0; asm volatile("" : "+s"(z)); return (int)__builtin_amdgcn_mbcnt_hi(~0u, __builtin_amdgcn_mbcnt_lo(~0u, z)); }
__device__ __forceinline__ u32x2 pack8_fp8(f32x4 a, f32x4 b, float sc) {
    int w0 = 0, w1 = 0;
    w0 = __builtin_amdgcn_cvt_pk_fp8_f32(a[0] * sc, a[1] * sc, w0, false); w0 = __builtin_amdgcn_cvt_pk_fp8_f32(a[2] * sc, a[3] * sc, w0, true);
    w1 = __builtin_amdgcn_cvt_pk_fp8_f32(b[0] * sc, b[1] * sc, w1, false); w1 = __builtin_amdgcn_cvt_pk_fp8_f32(b[2] * sc, b[3] * sc, w1, true);
    return (u32x2){(unsigned)w0, (unsigned)w1};
}
__device__ __forceinline__ void unpack8_fp8(u32x2 w, float isc, f32x4& a, f32x4& b) {
    const f32x2_t t0 = __builtin_amdgcn_cvt_pk_f32_fp8((int)w.x, false), t1 = __builtin_amdgcn_cvt_pk_f32_fp8((int)w.x, true);
    const f32x2_t t2 = __builtin_amdgcn_cvt_pk_f32_fp8((int)w.y, false), t3 = __builtin_amdgcn_cvt_pk_f32_fp8((int)w.y, true);
    a = (f32x4){t0[0] * isc, t0[1] * isc, t1[0] * isc, t1[1] * isc}; b = (f32x4){t2[0] * isc, t2[1] * isc, t3[0] * isc, t3[1] * isc};
}
__device__ __forceinline__ u32x2 pack8_u8(f32x4 a, f32x4 b) {
    unsigned w0 = 0, w1 = 0;
#pragma unroll
    for (int i = 0; i < 4; ++i) { w0 = __builtin_amdgcn_cvt_pk_u8_f32(__builtin_rintf(a[i] * 255.f), i, w0); w1 = __builtin_amdgcn_cvt_pk_u8_f32(__builtin_rintf(b[i] * 255.f), i, w1); }
    return (u32x2){w0, w1};
}
__device__ __forceinline__ void unpack8_u8(u32x2 w, f32x4& a, f32x4& b) {
    constexpr float k = 1.f / 255.f;
    a = (f32x4){(float)(w.x & 0xffu) * k, (float)((w.x >> 8) & 0xffu) * k, (float)((w.x >> 16) & 0xffu) * k, (float)(w.x >> 24) * k};
    b = (f32x4){(float)(w.y & 0xffu) * k, (float)((w.y >> 8) & 0xffu) * k, (float)((w.y >> 16) & 0xffu) * k, (float)(w.y >> 24) * k};
}
constexpr float MB_SC = 16.f, Y_SC = 16.f;
#define LDS_WAIT() asm volatile("s_waitcnt lgkmcnt(0)" ::: "memory")
#define VM_WAIT() asm volatile("s_waitcnt vmcnt(0)" ::: "memory")

#define XB_TMO      128
#define XB_XCNT(j)  (256  + 64 * (j))
#define XB_XSUB(j)  (1280 + 64 * (j))
#define XB_XGEN(j)  (2304 + 64 * (j))
#define XB_TOP      3328
#define XB_TOPGEN   3392
#define XCD_BAR_WORDS 3456
#define XB_SPIN_CAP (1u << 20)
__device__ __forceinline__ unsigned xb_ld(unsigned* p)              { return __hip_atomic_load(p, __ATOMIC_RELAXED, __HIP_MEMORY_SCOPE_AGENT); }
__device__ __forceinline__ unsigned xb_add(unsigned* p, unsigned v) { return __hip_atomic_fetch_add(p, v, __ATOMIC_RELAXED, __HIP_MEMORY_SCOPE_AGENT); }
__device__ __forceinline__ unsigned xb_xcc_id() { return (unsigned)__builtin_amdgcn_s_getreg((3 << 11) | 20) & 0xFu; }
#define XB_SPIN(cond, bar) do { unsigned _sp = 0; while (cond) { __builtin_amdgcn_s_sleep(1); \
    if ((++_sp & 255u) == 0u) { if (xb_ld(&(bar)[XB_TMO])) break; if (_sp > XB_SPIN_CAP) { atomicAdd(&(bar)[XB_TMO], 1u); break; } } } } while (0)
struct XcdBarrier { unsigned* bar; unsigned x; volatile LAS unsigned* st; };
__device__ __forceinline__ XcdBarrier xcd_barrier_post(unsigned* bar, volatile LAS unsigned* st) {
    XcdBarrier b; b.bar = bar; b.x = xb_xcc_id(); b.st = st;
    if (threadIdx.x == 0) (void)xb_add(&bar[XB_XCNT(b.x)], 1u);
    return b;
}
__device__ __forceinline__ void xcd_barrier_complete(unsigned* bar, unsigned x, unsigned& nloc, unsigned& nx) {
    const unsigned G = gridDim.x * gridDim.y * gridDim.z;
    unsigned sum, cnt, mine, sp = 0u;
    for (;;) {
        sum = 0u; cnt = 0u; mine = 0u;
#pragma unroll
        for (unsigned j = 0; j < 16; ++j) { const unsigned c = xb_ld(&bar[XB_XCNT(j)]); sum += c; cnt += (c > 0u) ? 1u : 0u; mine = (j == x) ? c : mine; }
        if (sum == G) break;
        __builtin_amdgcn_s_sleep(1);
        if ((++sp & 255u) == 0u) { if (xb_ld(&bar[XB_TMO])) break; if (sp > XB_SPIN_CAP) { atomicAdd(&bar[XB_TMO], 1u); break; } }
    }
    nloc = mine > 0u ? mine : 1u; nx = cnt > 0u ? cnt : 1u;
}
__device__ __forceinline__ void xcd_barrier(const XcdBarrier& b) {
    asm volatile("s_waitcnt vmcnt(0)" ::: "memory");
    __syncthreads();
    if (threadIdx.x == 0) {
        unsigned* bar = b.bar;
        __builtin_amdgcn_s_waitcnt(0);
        unsigned nloc = b.st[0], nx = b.st[1];
        if (nloc == 0u) { xcd_barrier_complete(bar, b.x, nloc, nx); b.st[0] = nloc; b.st[1] = nx; }
        const unsigned old = xb_add(&bar[XB_XSUB(b.x)], 1u);
        const unsigned gen = old / nloc;
        if (old + 1u == (gen + 1u) * nloc) {
            __builtin_amdgcn_fence(__ATOMIC_RELEASE, "agent");
            asm volatile("s_waitcnt vmcnt(0)" ::: "memory");
            const unsigned og = xb_add(&bar[XB_TOP], 1u);
            const unsigned tg = og / nx;
            if (og + 1u == (tg + 1u) * nx) xb_add(&bar[XB_TOPGEN], 1u);
            else XB_SPIN(xb_ld(&bar[XB_TOPGEN]) == tg, bar);
            __builtin_amdgcn_fence(__ATOMIC_ACQUIRE, "agent");
            xb_add(&bar[XB_XGEN(b.x)], 1u);
            asm volatile("s_waitcnt vmcnt(0)" ::: "memory");
        } else {
            XB_SPIN(xb_ld(&bar[XB_XGEN(b.x)]) == gen, bar);
            __builtin_amdgcn_fence(__ATOMIC_ACQUIRE, "agent");
            asm volatile("s_waitcnt vmcnt(0)" ::: "memory");
        }
    }
    __syncthreads();
}

namespace pg8 {
constexpr int BM = 256, BK = 64, HALF = 128, HTB = HALF * BK * 2, STAGE_BYTES = 8 * HTB, NXCD = 8, WGM = 8;
__device__ __forceinline__ int lds_byte(int r, int c) { const int st = (r >> 4) * 2 + (c >> 5), rr = r & 15, cc = c & 31, ob = rr * 64 + cc * 2; return st * 1024 + (ob ^ (((ob >> 9) & 1) << 5)); }
__device__ __forceinline__ void stage_rc(int b, int& R, int& C) { const int st = b / 1024, sb = b % 1024, swz = sb ^ (((sb >> 9) & 1) << 5); R = (st >> 1) * 16 + swz / 64; C = (st & 1) * 32 + (swz % 64) / 2; }
__device__ __forceinline__ int perm32(int rho) { const int n = rho >> 4, i = rho & 15; return 8 * (i >> 2) + 4 * n + (i & 3); }

struct Unit { int pm, pn, e, r0, nv, kind; };

struct DenseSched {
    static constexpr bool GATHER = false;
    const bf16_t* A; const bf16_t* Bt; int lda, ldb;
    int nM, nN, nwg, G, c, ntk = 0;
    __device__ __forceinline__ int nt(const Unit&) const { return ntk; }
    __device__ void init(const bf16_t* A_, int lda_, const bf16_t* Bt_, int ldb_, int M, int N, int G_, int c_) { A = A_; Bt = Bt_; lda = lda_; ldb = ldb_; nM = M / BM; nN = N / BM; nwg = nM * nN; G = G_; c = c_; }
    __device__ bool next(int i, Unit& u) const {
        const long L = (long)i * G + c; if (L >= nwg) return false;
        int wgid = (int)L; { const int q = nwg / NXCD, r = nwg % NXCD, xcd = wgid % NXCD, off = wgid / NXCD; wgid = (xcd < r ? xcd * (q + 1) : r * (q + 1) + (xcd - r) * q) + off; }
        const int nig = WGM * nN, gid = wgid / nig, fm = gid * WGM, gsz = (nM - fm) < WGM ? (nM - fm) : WGM;
        u.pm = fm + ((wgid % nig) % gsz); u.pn = (wgid % nig) / gsz; u.e = 0; u.r0 = 0; u.nv = 256; return true;
    }
    __device__ __forceinline__ const char* a_base(const Unit& u) const { return (const char*)(A + (size_t)u.pm * BM * lda); }
    __device__ __forceinline__ const char* b_base(const Unit& u) const { return (const char*)(Bt + (size_t)u.pn * BM * ldb); }
    __device__ __forceinline__ void a_rows(const Unit&, const int*, const int*, unsigned*, unsigned*) const {}
};
template <bool GATHER_, int NT>
struct GroupSched {
    static constexpr bool GATHER = GATHER_;
    const bf16_t* A; const bf16_t* Bt; int lda, ldb; size_t bstride;
    const int* ltok; const LAS int* tstart; const LAS int* cnt; const LAS int* tile_e; int nunits, G, c, ntk;
    __device__ __forceinline__ int nt(const Unit&) const { return ntk; }
    __device__ bool next(int i, Unit& u) const {
        const int L = i * G + c;
        if (L >= nunits) return false;
        const int tile = L / NT; u.pn = L % NT;
        const int e = __builtin_amdgcn_readfirstlane(tile_e[tile]);
        const int ts = __builtin_amdgcn_readfirstlane(tstart[e]), cn = __builtin_amdgcn_readfirstlane(cnt[e]);
        u.e = e; u.pm = tile; u.r0 = (tile - ts) * 256; const int rem = cn - u.r0; u.nv = rem < 256 ? rem : 256; return true;
    }
    __device__ __forceinline__ const char* a_base(const Unit& u) const { return GATHER ? (const char*)A : (const char*)(A + (size_t)u.pm * BM * lda); }
    __device__ __forceinline__ const char* b_base(const Unit& u) const { return (const char*)(Bt + (size_t)u.e * bstride + (size_t)u.pn * BM * ldb); }
    __device__ __forceinline__ void a_rows(const Unit& u, const int* R, const int* C, unsigned* v0, unsigned* v1) const {
        const int* lt = ltok + (size_t)u.e * CAP + u.r0;
#pragma unroll
        for (int i = 0; i < 2; ++i) {
            const int r0_ = R[i], r1_ = 128 + R[i];
            const int t0 = r0_ < u.nv ? (lt[r0_] >> 1) : 0;
            const int t1 = r1_ < u.nv ? (lt[r1_] >> 1) : 0;
            v0[i] = (unsigned)(t0 * lda + C[i]) * 2u; v1[i] = (unsigned)(t1 * lda + C[i]) * 2u;
        }
    }
};

struct MoeSched {
    const bf16_t* x1b; const bf16_t* mid; const bf16_t* Wgu; const bf16_t* Wd; const int* ltok; unsigned* tcnt;
    const LAS int* tstart; const LAS int* cnt; const LAS int* tile_e; int T, G, c;
    __device__ bool next(int i, Unit& u) const {
        const int full = (2 * T) / G, R3 = 2 * T - full * G, g = full + (c < R3 ? 1 : 0);
        int tile;
        if (i < g) { const int L = i * G + c; u.kind = 0; tile = L >> 1; u.pn = L & 1; }
        else { const int j = i - g, n_lo = G - R3; int d;
            if (R3 > 0 && c >= R3) d = j < 2 ? (c - R3) + n_lo * j : 2 * n_lo + c + G * (j - 2);
            else if (R3 > 0) d = 2 * n_lo + c + G * j;
            else d = c + G * j;
            if (d >= 4 * T) return false;
            u.kind = 1; tile = d >> 2; u.pn = d & 3; }
        const int e = __builtin_amdgcn_readfirstlane(tile_e[tile]);
        const int ts = __builtin_amdgcn_readfirstlane(tstart[e]), cn = __builtin_amdgcn_readfirstlane(cnt[e]);
        u.e = e; u.pm = tile; u.r0 = (tile - ts) * 256; const int rem = cn - u.r0; u.nv = rem < 256 ? rem : 256; return true;
    }
    __device__ __forceinline__ int nt(const Unit& u) const { return u.kind ? 4 : 16; }
    __device__ __forceinline__ int ldb(const Unit& u) const { return u.kind ? 256 : 1024; }
    __device__ __forceinline__ const char* a_base(const Unit& u) const { return u.kind ? (const char*)mid : (const char*)x1b; }
    __device__ __forceinline__ const char* b_base(const Unit& u) const {
        return u.kind ? (const char*)(Wd + (size_t)u.e * (1024 * 256) + (size_t)u.pn * (BM * 256)) : (const char*)(Wgu + (size_t)u.e * (512 * 1024) + (size_t)u.pn * (BM * 1024)); }
    __device__ __forceinline__ void a_rows(const Unit& u, const int* R, const int* C, unsigned* v0, unsigned* v1) const {
        if (u.kind) {
#pragma unroll
            for (int i = 0; i < 2; ++i) { v0[i] = (unsigned)((u.pm * BM + R[i]) * 256 + C[i]) * 2u; v1[i] = (unsigned)((u.pm * BM + 128 + R[i]) * 256 + C[i]) * 2u; }
        } else {
            const int* lt = ltok + (size_t)u.e * CAP + u.r0;
#pragma unroll
            for (int i = 0; i < 2; ++i) { const int r0_ = R[i], r1_ = 128 + R[i];
                const int t0 = r0_ < u.nv ? (lt[r0_] >> 1) : 0; const int t1 = r1_ < u.nv ? (lt[r1_] >> 1) : 0;
                v0[i] = (unsigned)(t0 * 1024 + C[i]) * 2u; v1[i] = (unsigned)(t1 * 1024 + C[i]) * 2u; }
        }
    }
    __device__ __forceinline__ void wait_ready(const Unit& u, bool& acquired) const {
        if (u.kind) {
            unsigned sp = 0;
            while ((unsigned)__builtin_amdgcn_readfirstlane((int)__hip_atomic_load(tcnt + u.pm, __ATOMIC_RELAXED, __HIP_MEMORY_SCOPE_AGENT)) < 2u) { __builtin_amdgcn_s_sleep(2); if (++sp > (1u << 22)) break; }
            if (!acquired) { __builtin_amdgcn_fence(__ATOMIC_ACQUIRE, "agent"); acquired = true; }
            asm volatile("" ::: "memory");
        }
    }
    __device__ __forceinline__ void publish(const Unit& u, int wid) const {
        if (!u.kind) {
            asm volatile("s_waitcnt vmcnt(0)" ::: "memory");
            __builtin_amdgcn_s_barrier();
            asm volatile("" ::: "memory");
            if (wid == 0 && lane_id_fresh() == 0) __hip_atomic_fetch_add(tcnt + u.pm, 1u, __ATOMIC_RELAXED, __HIP_MEMORY_SCOPE_AGENT);
        }
    }
};

struct QkvSched : DenseSched {
    __device__ __forceinline__ int nt(const Unit& u) const { return u.pn < 3 ? 4 : 2; }
    __device__ __forceinline__ const char* a_base(const Unit& u) const { return (const char*)(A + (size_t)u.pm * BM * lda + (u.pn < 3 ? 0 : 256)); }
};
struct YSched {
    static constexpr bool GATHER = false;
    const bf16_t* Ab; const bf16_t* Aa; const bf16_t* Bb; const bf16_t* Ba; int lda, ldb, G, c, nper;
    __device__ __forceinline__ int nt(const Unit&) const { return 8; }
    __device__ bool next(int i, Unit& u) const {
        if (i >= 2 * nper) return false;
        const int kind = i >= nper ? 1 : 0, tile = (kind ? i - nper : i) * G + c;
        if (tile >= 512) return false;
        int wgid = tile; { const int q = 512 / NXCD, xcd = wgid % NXCD, off = wgid / NXCD; wgid = xcd * q + off; }
        const int nig = WGM * 4, gid = wgid / nig, fm = gid * WGM;
        u.pm = fm + ((wgid % nig) % WGM); u.pn = (wgid % nig) / WGM; u.e = kind; u.r0 = 0; u.nv = 256; return true;
    }
    __device__ __forceinline__ const char* a_base(const Unit& u) const { return (const char*)((u.e ? Aa : Ab) + (size_t)u.pm * BM * lda); }
    __device__ __forceinline__ const char* b_base(const Unit& u) const { return (const char*)((u.e ? Ba : Bb) + (size_t)u.pn * BM * ldb); }
    __device__ __forceinline__ void a_rows(const Unit&, const int*, const int*, unsigned*, unsigned*) const {}
};

template <class Epi, class Sched, bool ALIGN_EPI, bool FP8 = false>
__device__ __forceinline__ void gemm_phase(LAS unsigned char* lds, const int wave_, const int K, const Sched& S, const Epi& E) {
    constexpr bool GATHER = Sched::GATHER;
    const int wid = wave_, lane = lane_id_fresh(), tid = wid * 64 + lane, wr = wid >> 2, wc = wid & 3, fr = lane & 15, fq = lane >> 4;
    const int lda = S.lda, ldb = S.ldb; (void)K;
    unsigned voffA[2], voffB[2]; int sR[2], sC[2];
#pragma unroll
    for (int i = 0; i < 2; ++i) { int R, C; stage_rc(tid * 16 + i * 8192, R, C); sR[i] = R; sC[i] = C; const int Rb = (R & ~31) + perm32(R & 31);
        voffA[i] = (unsigned)(R * lda + C) * 2u; voffB[i] = (unsigned)(Rb * ldb + C) * 2u; }
    const size_t kstep = (size_t)(BK * 2);
    const size_t hstepA = (size_t)HALF * lda * 2, hstepB = (size_t)HALF * ldb * 2;
    const unsigned ldsw = (unsigned)wid * 1024u;
    const int aoff = lds_byte(wr * 64 + fr, fq * 8), boff = lds_byte(wc * 32 + fr, fq * 8);
    unsigned cg0[2] = {0, 0}, cg1[2] = {0, 0}, ng0[2] = {0, 0}, ng1[2] = {0, 0};
#define PG8_SA(b, h) (((b) * 2 + (h)) * HTB)
#define PG8_SB(b, h) ((4 + (b) * 2 + (h)) * HTB)
#define PG8_GLDS(gp, bufoff, _i) __builtin_amdgcn_global_load_lds((const unsigned*)(gp), (LAS unsigned*)(lds + (bufoff) + ldsw + (_i) * 8192), 16, 0, 0)
#define PG8_STAGE_B(bufoff, gbase) do { _Pragma("unroll") for (int _i = 0; _i < 2; ++_i) PG8_GLDS((const char*)(gbase) + voffB[_i], bufoff, _i); } while (0)
#define PG8_STAGE_A(bufoff, kptr, h, nx) do { _Pragma("unroll") for (int _i = 0; _i < 2; ++_i) { const char* p_; \
        if constexpr (GATHER) p_ = (const char*)(kptr) + ((nx) ? ((h) ? ng1[_i] : ng0[_i]) : ((h) ? cg1[_i] : cg0[_i])); \
        else p_ = (const char*)(kptr) + (h) * hstepA + voffA[_i]; PG8_GLDS(p_, bufoff, _i); } } while (0)
#define PG8_LDA(dst, b, h) do { _Pragma("unroll") for (int m = 0; m < 4; ++m) { if constexpr (FP8) { const u32x4 l_ = *(const LAS u32x4*)(lds + PG8_SA(b, h) + aoff + m * 2048), h_ = *(const LAS u32x4*)(lds + PG8_SA(b, h) + aoff + m * 2048 + 1024); \
        dst##8[m] = (v8i32){(int)l_.x, (int)l_.y, (int)l_.z, (int)l_.w, (int)h_.x, (int)h_.y, (int)h_.z, (int)h_.w}; } \
        else { _Pragma("unroll") for (int k = 0; k < 2; ++k) dst[m][k] = *(const LAS bf16x8*)(lds + PG8_SA(b, h) + aoff + m * 2048 + k * 1024); } } } while (0)
#define PG8_LDB(dst, b, h) do { _Pragma("unroll") for (int n = 0; n < 2; ++n) { if constexpr (FP8) { const u32x4 l_ = *(const LAS u32x4*)(lds + PG8_SB(b, h) + boff + n * 2048), h_ = *(const LAS u32x4*)(lds + PG8_SB(b, h) + boff + n * 2048 + 1024); \
        dst##8[n] = (v8i32){(int)l_.x, (int)l_.y, (int)l_.z, (int)l_.w, (int)h_.x, (int)h_.y, (int)h_.z, (int)h_.w}; } \
        else { _Pragma("unroll") for (int k = 0; k < 2; ++k) dst[n][k] = *(const LAS bf16x8*)(lds + PG8_SB(b, h) + boff + n * 2048 + k * 1024); } } } while (0)
#define PG8_MMA(ai, bj, At, Bt) do { __builtin_amdgcn_s_setprio(1); _Pragma("unroll") for (int m = 0; m < 4; ++m) _Pragma("unroll") for (int n = 0; n < 2; ++n) { \
        if constexpr (FP8) acc[ai][bj][m][n] = __builtin_amdgcn_mfma_scale_f32_16x16x128_f8f6f4(Bt##8[n], At##8[m], acc[ai][bj][m][n], 0, 0, 0, 0x7f7f7f7f, 0, 0x7f7f7f7f); \
        else { _Pragma("unroll") for (int k = 0; k < 2; ++k) acc[ai][bj][m][n] = __builtin_amdgcn_mfma_f32_16x16x32_bf16(Bt[n][k], At[m][k], acc[ai][bj][m][n], 0, 0, 0); } } \
        if constexpr (FP8) { _Pragma("unroll") for (int m = 0; m < 4; ++m) asm volatile("" : "+v"(acc[ai][bj][m][0]), "+v"(acc[ai][bj][m][1])); } \
        __builtin_amdgcn_s_setprio(0); } while (0)
#define PG8_WAIT_V(n) asm volatile("s_waitcnt vmcnt(" #n ")" ::: "memory")
#define PG8_WAIT_L(n) asm volatile("s_waitcnt lgkmcnt(" #n ")" ::: "memory")
#define PG8_BAR __builtin_amdgcn_s_barrier()
#define PG8_SCHED __builtin_amdgcn_sched_barrier(0)
    Unit cur, nxt; int ui = 0;
    if (!S.next(0, cur)) return;
    f32x4 acc[2][2][4][2];
#pragma unroll
    for (int a = 0; a < 2; ++a)
#pragma unroll
        for (int b = 0; b < 2; ++b)
#pragma unroll
            for (int m = 0; m < 4; ++m)
#pragma unroll
                for (int n = 0; n < 2; ++n) acc[a][b][m][n] = (f32x4){0.f, 0.f, 0.f, 0.f};
    bf16x8 At[4][2], B0[2][2], B1[2][2]; v8i32 At8[4], B08[2], B18[2]; (void)At; (void)B0; (void)B1; (void)At8; (void)B08; (void)B18;
    const char* cA = S.a_base(cur); const char* cB = S.b_base(cur);
    if constexpr (GATHER) { S.a_rows(cur, sR, sC, cg0, cg1); }
    PG8_STAGE_B(PG8_SB(0, 0), cB); PG8_STAGE_B(PG8_SB(0, 1), cB + hstepB); PG8_STAGE_A(PG8_SA(0, 0), cA, 0, false); PG8_STAGE_A(PG8_SA(0, 1), cA, 1, false);
    if (wr == 1) PG8_BAR;
    PG8_WAIT_V(2); PG8_BAR;
    PG8_STAGE_B(PG8_SB(1, 0), cB + kstep); PG8_STAGE_A(PG8_SA(1, 0), cA + kstep, 0, false); PG8_STAGE_B(PG8_SB(1, 1), cB + hstepB + kstep);
    PG8_WAIT_V(6); PG8_BAR;
    for (;;) {
        const bool has_next = S.next(ui + 1, nxt);
        const char* nA = has_next ? S.a_base(nxt) : cA; const char* nB = has_next ? S.b_base(nxt) : cB;
        if constexpr (GATHER) { if (has_next) S.a_rows(nxt, sR, sC, ng0, ng1); else { ng0[0] = cg0[0]; ng0[1] = cg0[1]; ng1[0] = cg1[0]; ng1[1] = cg1[1]; } }
        const int nt = S.nt(cur);
        for (int t = 0; t < nt; t += 2) {
            const bool last = (t == nt - 2);
            const char* a1 = cA + (size_t)(t + 1) * kstep;
            const char* a2 = last ? nA : cA + (size_t)(t + 2) * kstep; const char* b2 = last ? nB : cB + (size_t)(t + 2) * kstep;
            const char* a3 = a2 + kstep; const char* b3 = b2 + kstep;
            PG8_LDB(B0, 0, 0); PG8_LDB(B1, 0, 1); PG8_SCHED; PG8_LDA(At, 0, 0); PG8_STAGE_A(PG8_SA(1, 1), a1, 1, false);
            PG8_WAIT_V(8); PG8_WAIT_L(0); PG8_BAR; PG8_MMA(0, 0, At, B0); PG8_MMA(0, 1, At, B1); PG8_BAR; PG8_SCHED;
            PG8_LDA(At, 0, 1); PG8_STAGE_B(PG8_SB(0, 0), b2); PG8_STAGE_B(PG8_SB(0, 1), b2 + hstepB); PG8_STAGE_A(PG8_SA(0, 0), a2, 0, last);
            PG8_WAIT_V(8); PG8_WAIT_L(0); PG8_BAR; PG8_MMA(1, 0, At, B0); PG8_MMA(1, 1, At, B1); PG8_BAR; PG8_SCHED;
            PG8_LDB(B0, 1, 0); PG8_LDB(B1, 1, 1); PG8_SCHED; PG8_LDA(At, 1, 0); PG8_STAGE_A(PG8_SA(0, 1), a2, 1, last);
            PG8_WAIT_V(8); PG8_WAIT_L(0); PG8_BAR; PG8_MMA(0, 0, At, B0); PG8_MMA(0, 1, At, B1); PG8_BAR; PG8_SCHED;
            PG8_LDA(At, 1, 1); PG8_STAGE_B(PG8_SB(1, 0), b3); PG8_STAGE_B(PG8_SB(1, 1), b3 + hstepB); PG8_STAGE_A(PG8_SA(1, 0), a3, 0, last);
            PG8_WAIT_V(8); PG8_WAIT_L(0); PG8_BAR; PG8_MMA(1, 0, At, B0); PG8_MMA(1, 1, At, B1); PG8_BAR; PG8_SCHED;
        }
        if constexpr (ALIGN_EPI) { if (wr == 0) PG8_BAR; }
        { const int l2_ = lane_id_fresh(); E(acc, cur, wr, wc, l2_ & 15, l2_ >> 4); }
        if (!has_next) break;
#pragma unroll
        for (int a = 0; a < 2; ++a)
#pragma unroll
            for (int b = 0; b < 2; ++b)
#pragma unroll
                for (int m = 0; m < 4; ++m)
#pragma unroll
                    for (int n = 0; n < 2; ++n) acc[a][b][m][n] = (f32x4){0.f, 0.f, 0.f, 0.f};
        cur = nxt; cA = nA; cB = nB; ++ui;
        if constexpr (GATHER) { cg0[0] = ng0[0]; cg0[1] = ng0[1]; cg1[0] = ng1[0]; cg1[1] = ng1[1]; }
        if constexpr (ALIGN_EPI) { if (wr == 1) PG8_BAR; }
    }
    PG8_WAIT_V(0);
    if constexpr (!ALIGN_EPI) { if (wr == 0) PG8_BAR; }
    PG8_BAR;
#undef PG8_SA
#undef PG8_SB
#undef PG8_GLDS
#undef PG8_STAGE_A
#undef PG8_STAGE_B
#undef PG8_LDA
#undef PG8_LDB
#undef PG8_MMA
#undef PG8_WAIT_V
#undef PG8_WAIT_L
#undef PG8_BAR
#undef PG8_SCHED
}

template <class Epi, class Sched>
__device__ __forceinline__ void gemm_phase_moe(LAS unsigned char* lds, const int wave_, const Sched& S, const Epi& E) {
    constexpr bool GATHER = true, ALIGN_EPI = true;
    const int wid = wave_, lane = lane_id_fresh(), tid = wid * 64 + lane, wr = wid >> 2, wc = wid & 3, fr = lane & 15, fq = lane >> 4;
    int sR[2], sC[2];
#pragma unroll
    for (int i = 0; i < 2; ++i) { int R, C; stage_rc(tid * 16 + i * 8192, R, C); sR[i] = R; sC[i] = C; }
    const size_t kstep = (size_t)(BK * 2);
    unsigned cvB[2] = {0, 0}, nvB[2] = {0, 0}; unsigned chB = 0, nhB = 0;
#define PG8_SET_B(u, vB, hB) do { const int ldb_ = S.ldb(u); hB = (unsigned)(HALF * ldb_ * 2); _Pragma("unroll") for (int _i = 0; _i < 2; ++_i) vB[_i] = (unsigned)(((sR[_i] & ~31) + perm32(sR[_i] & 31)) * ldb_ + sC[_i]) * 2u; } while (0)
    const unsigned ldsw = (unsigned)wid * 1024u;
    const int aoff = lds_byte(wr * 64 + fr, fq * 8), boff = lds_byte(wc * 32 + fr, fq * 8);
    unsigned cg0[2] = {0, 0}, cg1[2] = {0, 0}, ng0[2] = {0, 0}, ng1[2] = {0, 0};
#define PG8_SA(b, h) (((b) * 2 + (h)) * HTB)
#define PG8_SB(b, h) ((4 + (b) * 2 + (h)) * HTB)
#define PG8_GLDS(gp, bufoff, _i) __builtin_amdgcn_global_load_lds((const unsigned*)(gp), (LAS unsigned*)(lds + (bufoff) + ldsw + (_i) * 8192), 16, 0, 0)
#define PG8_STAGE_B(bufoff, kptr, h, nx) do { _Pragma("unroll") for (int _i = 0; _i < 2; ++_i) PG8_GLDS((const char*)(kptr) + ((h) ? ((nx) ? nhB : chB) : 0u) + ((nx) ? nvB[_i] : cvB[_i]), bufoff, _i); } while (0)
#define PG8_STAGE_A(bufoff, kptr, h, nx) do { _Pragma("unroll") for (int _i = 0; _i < 2; ++_i) { const char* p_; \
        p_ = (const char*)(kptr) + ((nx) ? ((h) ? ng1[_i] : ng0[_i]) : ((h) ? cg1[_i] : cg0[_i])); PG8_GLDS(p_, bufoff, _i); } } while (0)
#define PG8_LDA(dst, b, h) do { _Pragma("unroll") for (int m = 0; m < 4; ++m) _Pragma("unroll") for (int k = 0; k < 2; ++k) dst[m][k] = *(const LAS bf16x8*)(lds + PG8_SA(b, h) + aoff + m * 2048 + k * 1024); } while (0)
#define PG8_LDB(dst, b, h) do { _Pragma("unroll") for (int n = 0; n < 2; ++n) _Pragma("unroll") for (int k = 0; k < 2; ++k) dst[n][k] = *(const LAS bf16x8*)(lds + PG8_SB(b, h) + boff + n * 2048 + k * 1024); } while (0)
#define PG8_MMA(ai, bj, At, Bt) do { __builtin_amdgcn_s_setprio(1); _Pragma("unroll") for (int m = 0; m < 4; ++m) _Pragma("unroll") for (int n = 0; n < 2; ++n) _Pragma("unroll") for (int k = 0; k < 2; ++k) \
        acc[ai][bj][m][n] = __builtin_amdgcn_mfma_f32_16x16x32_bf16(Bt[n][k], At[m][k], acc[ai][bj][m][n], 0, 0, 0); __builtin_amdgcn_s_setprio(0); } while (0)
#define PG8_WAIT_V(n) asm volatile("s_waitcnt vmcnt(" #n ")" ::: "memory")
#define PG8_WAIT_L(n) asm volatile("s_waitcnt lgkmcnt(" #n ")" ::: "memory")
#define PG8_BAR __builtin_amdgcn_s_barrier()
#define PG8_SCHED __builtin_amdgcn_sched_barrier(0)
    Unit cur, nxt; int ui = 0;
    if (!S.next(0, cur)) return;
    f32x4 acc[2][2][4][2];
#pragma unroll
    for (int a = 0; a < 2; ++a)
#pragma unroll
        for (int b = 0; b < 2; ++b)
#pragma unroll
            for (int m = 0; m < 4; ++m)
#pragma unroll
                for (int n = 0; n < 2; ++n) acc[a][b][m][n] = (f32x4){0.f, 0.f, 0.f, 0.f};
    bf16x8 At[4][2], B0[2][2], B1[2][2];
    const char* cA = S.a_base(cur); const char* cB = S.b_base(cur);
    bool acquired = false;
    S.wait_ready(cur, acquired);
    S.a_rows(cur, sR, sC, cg0, cg1); PG8_SET_B(cur, cvB, chB);
    PG8_STAGE_B(PG8_SB(0, 0), cB, 0, false); PG8_STAGE_B(PG8_SB(0, 1), cB, 1, false); PG8_STAGE_A(PG8_SA(0, 0), cA, 0, false); PG8_STAGE_A(PG8_SA(0, 1), cA, 1, false);
    if (wr == 1) PG8_BAR;
    PG8_WAIT_V(2); PG8_BAR;
    PG8_STAGE_B(PG8_SB(1, 0), cB + kstep, 0, false); PG8_STAGE_A(PG8_SA(1, 0), cA + kstep, 0, false); PG8_STAGE_B(PG8_SB(1, 1), cB + kstep, 1, false);
    PG8_WAIT_V(6); PG8_BAR;
    for (;;) {
        const bool has_next = S.next(ui + 1, nxt);
        const char* nA = has_next ? S.a_base(nxt) : cA; const char* nB = has_next ? S.b_base(nxt) : cB;
        if (has_next) { S.wait_ready(nxt, acquired); S.a_rows(nxt, sR, sC, ng0, ng1); PG8_SET_B(nxt, nvB, nhB); }
        else { ng0[0] = cg0[0]; ng0[1] = cg0[1]; ng1[0] = cg1[0]; ng1[1] = cg1[1]; nvB[0] = cvB[0]; nvB[1] = cvB[1]; nhB = chB; }
        const int nt = S.nt(cur);
        for (int t = 0; t < nt; t += 2) {
            const bool last = (t == nt - 2);
            const char* a1 = cA + (size_t)(t + 1) * kstep;
            const char* a2 = last ? nA : cA + (size_t)(t + 2) * kstep; const char* b2 = last ? nB : cB + (size_t)(t + 2) * kstep;
            const char* a3 = a2 + kstep; const char* b3 = b2 + kstep;
            PG8_LDB(B0, 0, 0); PG8_LDB(B1, 0, 1); PG8_SCHED; PG8_LDA(At, 0, 0); PG8_STAGE_A(PG8_SA(1, 1), a1, 1, false);
            PG8_WAIT_V(8); PG8_WAIT_L(0); PG8_BAR; PG8_MMA(0, 0, At, B0); PG8_MMA(0, 1, At, B1); PG8_BAR; PG8_SCHED;
            PG8_LDA(At, 0, 1); PG8_STAGE_B(PG8_SB(0, 0), b2, 0, last); PG8_STAGE_B(PG8_SB(0, 1), b2, 1, last); PG8_STAGE_A(PG8_SA(0, 0), a2, 0, last);
            PG8_WAIT_V(8); PG8_WAIT_L(0); PG8_BAR; PG8_MMA(1, 0, At, B0); PG8_MMA(1, 1, At, B1); PG8_BAR; PG8_SCHED;
            PG8_LDB(B0, 1, 0); PG8_LDB(B1, 1, 1); PG8_SCHED; PG8_LDA(At, 1, 0); PG8_STAGE_A(PG8_SA(0, 1), a2, 1, last);
            PG8_WAIT_V(8); PG8_WAIT_L(0); PG8_BAR; PG8_MMA(0, 0, At, B0); PG8_MMA(0, 1, At, B1); PG8_BAR; PG8_SCHED;
            PG8_LDA(At, 1, 1); PG8_STAGE_B(PG8_SB(1, 0), b3, 0, last); PG8_STAGE_B(PG8_SB(1, 1), b3, 1, last); PG8_STAGE_A(PG8_SA(1, 0), a3, 0, last);
            PG8_WAIT_V(8); PG8_WAIT_L(0); PG8_BAR; PG8_MMA(1, 0, At, B0); PG8_MMA(1, 1, At, B1); PG8_BAR; PG8_SCHED;
        }
        if constexpr (ALIGN_EPI) { if (wr == 0) PG8_BAR; }
        { const int l2_ = lane_id_fresh(); E(acc, cur, wr, wc, l2_ & 15, l2_ >> 4); }
        S.publish(cur, wid);
        if (!has_next) break;
#pragma unroll
        for (int a = 0; a < 2; ++a)
#pragma unroll
            for (int b = 0; b < 2; ++b)
#pragma unroll
                for (int m = 0; m < 4; ++m)
#pragma unroll
                    for (int n = 0; n < 2; ++n) acc[a][b][m][n] = (f32x4){0.f, 0.f, 0.f, 0.f};
        cur = nxt; cA = nA; cB = nB; ++ui;
        cg0[0] = ng0[0]; cg0[1] = ng0[1]; cg1[0] = ng1[0]; cg1[1] = ng1[1]; cvB[0] = nvB[0]; cvB[1] = nvB[1]; chB = nhB;
        if constexpr (ALIGN_EPI) { if (wr == 1) PG8_BAR; }
    }
    PG8_WAIT_V(0);
    if constexpr (!ALIGN_EPI) { if (wr == 0) PG8_BAR; }
    PG8_BAR;
#undef PG8_SET_B
#undef PG8_SA
#undef PG8_SB
#undef PG8_GLDS
#undef PG8_STAGE_A
#undef PG8_STAGE_B
#undef PG8_LDA
#undef PG8_LDB
#undef PG8_MMA
#undef PG8_WAIT_V
#undef PG8_WAIT_L
#undef PG8_BAR
#undef PG8_SCHED
}


typedef f32x4 Acc[2][2][4][2];

struct EpiG1 {
    bf16_t* qkvd; bf16_t* u; unsigned char* gates; const float* bg; const float* rstd1;
    float* ssq_kv; float* ssq_rope; bf16_t* krr; const float* cstab; const float* gk;
    __device__ __forceinline__ void operator()(const Acc& acc, const Unit& un, int wr, int wc, int fr, int fq) const {
        const int row0 = un.pm * BM + wr * 64 + fr, c8 = wc * 32 + 8 * fq, pn = un.pn;
        if (pn < 2) {
#pragma unroll
            for (int ai = 0; ai < 2; ++ai)
#pragma unroll
                for (int m = 0; m < 4; ++m) { const int row = row0 + ai * HALF + m * 16; bf16_t* rowp = qkvd + (size_t)row * 512 + pn * 256 + c8;
                    f32x4 v[2][2];
#pragma unroll
                    for (int bj = 0; bj < 2; ++bj) { v[bj][0] = acc[ai][bj][m][0]; v[bj][1] = acc[ai][bj][m][1]; store8(rowp + bj * HALF, v[bj][0], v[bj][1]); }
                    if (pn == 1) {
                        float ss = (v[0][0][0] * v[0][0][0] + v[0][0][1] * v[0][0][1]) + (v[0][0][2] * v[0][0][2] + v[0][0][3] * v[0][0][3]) + (v[0][1][0] * v[0][1][0] + v[0][1][1] * v[0][1][1]) + (v[0][1][2] * v[0][1][2] + v[0][1][3] * v[0][1][3]);
                        ss += __shfl_xor(ss, 16); ss += __shfl_xor(ss, 32);
                        if (fq == 0) ssq_kv[(size_t)row * 4 + wc] = ss;
                        if (wc == 0) {
                            float kv_[8], sr = 0.f;
#pragma unroll
                            for (int n = 0; n < 2; ++n)
#pragma unroll
                                for (int i = 0; i < 4; ++i) { const float t = v[1][n][i]; sr += t * t; kv_[4 * n + i] = t * gk[64 + 8 * fq + 4 * n + i]; }
                            sr += __shfl_xor(sr, 16); sr += __shfl_xor(sr, 32);
                            if (fq == 0) ssq_rope[row] = sr;
                            const float* cs = cstab + (size_t)row * 32 + 8 * (fq & 1);
                            const f32x4 c0 = *(const f32x4*)cs, c1 = *(const f32x4*)(cs + 4), s0 = *(const f32x4*)(cs + 16), s1 = *(const f32x4*)(cs + 20);
                            f32x4 o0, o1;
#pragma unroll
                            for (int i = 0; i < 4; ++i) { const float p0 = __shfl_xor(kv_[i], 32), p1 = __shfl_xor(kv_[4 + i], 32);
                                o0[i] = fq < 2 ? kv_[i] * c0[i] - p0 * s0[i] : kv_[i] * c0[i] + p0 * s0[i];
                                o1[i] = fq < 2 ? kv_[4 + i] * c1[i] - p1 * s1[i] : kv_[4 + i] * c1[i] + p1 * s1[i]; }
                            store8(krr + (size_t)row * 32 + 8 * fq, o0, o1);
                        } } }
        } else if (pn < 6) {
            const int t = pn - 2;
#pragma unroll
            for (int ai = 0; ai < 2; ++ai)
#pragma unroll
                for (int m = 0; m < 4; ++m) { f32x4 o[2];
#pragma unroll
                    for (int n = 0; n < 2; ++n) { const f32x4 v = acc[ai][0][m][n], g = acc[ai][1][m][n];
#pragma unroll
                        for (int i = 0; i < 4; ++i) o[n][i] = v[i] * sigmoidf_(g[i]); }
                    store8h(u + (size_t)(row0 + ai * HALF + m * 16) * 512 + t * 128 + c8, o[0], o[1]); }
        } else {
            const int gcol = (pn - 6) * 256;
#pragma unroll
            for (int bj = 0; bj < 2; ++bj) {
                const f32x4 b0 = *(const f32x4*)(bg + gcol + bj * HALF + c8), b1 = *(const f32x4*)(bg + gcol + bj * HALF + c8 + 4);
#pragma unroll
                for (int ai = 0; ai < 2; ++ai)
#pragma unroll
                    for (int m = 0; m < 4; ++m) { f32x4 o0, o1;
#pragma unroll
                        for (int i = 0; i < 4; ++i) { o0[i] = sigmoidf_(acc[ai][bj][m][0][i] + b0[i]); o1[i] = sigmoidf_(acc[ai][bj][m][1][i] + b1[i]); }
                        *(u32x2*)(gates + (size_t)(row0 + ai * HALF + m * 16) * 2048 + gcol + bj * HALF + c8) = pack8_u8(o0, o1); }
            }
        }
    }
};
struct EpiGates {
    unsigned char* gates; const float* bg;
    __device__ __forceinline__ void operator()(const Acc& acc, const Unit& un, int wr, int wc, int fr, int fq) const {
        const int row0 = un.pm * BM + wr * 64 + fr, c8 = wc * 32 + 8 * fq, gcol = un.pn * 256;
        constexpr float L2E = 1.4426950408889634f, K255 = 1.f / 255.f;
#pragma unroll
        for (int bj = 0; bj < 2; ++bj) {
            const f32x4 b0 = *(const f32x4*)(bg + gcol + bj * HALF + c8) * -L2E, b1 = *(const f32x4*)(bg + gcol + bj * HALF + c8 + 4) * -L2E;
#pragma unroll
            for (int ai = 0; ai < 2; ++ai)
#pragma unroll
                for (int m = 0; m < 4; ++m) { unsigned w0 = 0, w1 = 0;
#pragma unroll
                    for (int i = 0; i < 4; ++i) {
                        const float e0 = __builtin_amdgcn_exp2f(fmaf(acc[ai][bj][m][0][i], -0.0625f * L2E, b0[i])), e1 = __builtin_amdgcn_exp2f(fmaf(acc[ai][bj][m][1][i], -0.0625f * L2E, b1[i]));
                        w0 = __builtin_amdgcn_cvt_pk_u8_f32(__builtin_rintf(__builtin_amdgcn_rcpf(fmaf(e0, K255, K255))), i, w0);
                        w1 = __builtin_amdgcn_cvt_pk_u8_f32(__builtin_rintf(__builtin_amdgcn_rcpf(fmaf(e1, K255, K255))), i, w1); }
                    *(u32x2*)(gates + (size_t)(row0 + ai * HALF + m * 16) * 2048 + gcol + bj * HALF + c8) = (u32x2){w0, w1}; }
        }
    }
};
struct EpiPlain {
    bf16_t* O; int ldc;
    __device__ __forceinline__ void operator()(const Acc& acc, const Unit& un, int wr, int wc, int fr, int fq) const {
        asm volatile("" : "+v"(fr), "+v"(fq));
        const int row0 = un.pm * BM + wr * 64 + fr, c8 = un.pn * BM + wc * 32 + 8 * fq;
#pragma unroll
        for (int ai = 0; ai < 2; ++ai)
#pragma unroll
            for (int m = 0; m < 4; ++m) { bf16_t* rowp = O + (size_t)(row0 + ai * HALF + m * 16) * ldc + c8;
#pragma unroll
                for (int bj = 0; bj < 2; ++bj) store8(rowp + bj * HALF, acc[ai][bj][m][0], acc[ai][bj][m][1]); }
    }
};
__device__ __forceinline__ int kimg_off(int r, int c) { return r * 192 + ((c ^ ((r >> 2) & 3)) << 4); }
__device__ __forceinline__ int vimg_off(int k, int c) { const int kk = (k & ~0xC) | ((k & 4) << 1) | ((k & 8) >> 1); return ((kk >> 3) * 2 + (c >> 5)) * 512 + ((kk & 7) * 32 + (c & 31)) * 2; }
struct EpiKV {
    const float* ssq_kv; const float* ssq_rope; const bf16_t* krr; const float* gk; bf16_t* K; bf16_t* V;
    __device__ __forceinline__ void operator()(const Acc& acc, const Unit& un, int wr, int wc, int fr, int fq) const {
        const int row0 = un.pm * BM + wr * 64 + fr, head = 2 * un.pn + (wc & 1);
        if (wc >= 2) {
            float sk[8];
#pragma unroll
            for (int q = 0; q < 8; ++q) { const f32x4 p4 = *(const f32x4*)(ssq_kv + (size_t)(row0 + (q >> 2) * HALF + (q & 3) * 16) * 4); sk[q] = (p4[0] + p4[1]) + (p4[2] + p4[3]); }
#pragma unroll
            for (int q = 0; q < 8; ++q) { const int ai = q >> 2, m = q & 3, row = row0 + ai * HALF + m * 16; const float rkv = __builtin_amdgcn_rsqf(sk[q] * (1.f / KVLR) + EPS);
                const int t = row & (SEQ - 1);
                char* dst = (char*)(V + (size_t)((row >> 11) * NH + head) * SEQ * 64) + (size_t)(t >> 6) * 8192;
#pragma unroll
                for (int bj = 0; bj < 2; ++bj) store8((bf16_t*)(dst + vimg_off(t & 63, 32 * bj + 8 * fq)), acc[ai][bj][m][0] * rkv, acc[ai][bj][m][1] * rkv); }
        } else {
            f32x4 g[2][2];
#pragma unroll
            for (int bj = 0; bj < 2; ++bj)
#pragma unroll
                for (int n = 0; n < 2; ++n) g[bj][n] = *(const f32x4*)(gk + 32 * bj + 8 * fq + 4 * n);
#pragma unroll
            for (int ai = 0; ai < 2; ++ai) {
                float sk[4], sr[4]; u32x4 KR[4];
#pragma unroll
                for (int m = 0; m < 4; ++m) { const int row = row0 + ai * HALF + m * 16; { const f32x4 p4 = *(const f32x4*)(ssq_kv + (size_t)row * 4); sk[m] = (p4[0] + p4[1]) + (p4[2] + p4[3]); } sr[m] = ssq_rope[row]; KR[m] = *(const u32x4*)(krr + (size_t)row * 32 + 8 * fq); }
#pragma unroll
                for (int m = 0; m < 4; ++m) { const int row = row0 + ai * HALF + m * 16; const float rkv = __builtin_amdgcn_rsqf(sk[m] * (1.f / KVLR) + EPS);
                    f32x4 v[2][2]; float ss = 0.f;
#pragma unroll
                    for (int bj = 0; bj < 2; ++bj)
#pragma unroll
                        for (int n = 0; n < 2; ++n) { v[bj][n] = acc[ai][bj][m][n] * rkv; ss += (v[bj][n][0] * v[bj][n][0] + v[bj][n][1] * v[bj][n][1]) + (v[bj][n][2] * v[bj][n][2] + v[bj][n][3] * v[bj][n][3]); }
                    ss += __shfl_xor(ss, 16); ss += __shfl_xor(ss, 32);
                    const float rh = __builtin_amdgcn_rsqf((ss + sr[m]) * (1.f / 96.f) + EPS);
                    const int t = row & (SEQ - 1), r = t & 63;
                    char* dst = (char*)(K + (size_t)((row >> 11) * NH + head) * SEQ * 96) + (size_t)(t >> 6) * 12288;
#pragma unroll
                    for (int bj = 0; bj < 2; ++bj) store8((bf16_t*)(dst + kimg_off(r, 4 * bj + fq)), v[bj][0] * g[bj][0] * rh, v[bj][1] * g[bj][1] * rh);
                    const u32x4 kw = KR[m]; const f32x4 k0 = (f32x4){bf_lo(kw.x), bf_hi(kw.x), bf_lo(kw.y), bf_hi(kw.y)}, k1 = (f32x4){bf_lo(kw.z), bf_hi(kw.z), bf_lo(kw.w), bf_hi(kw.w)};
                    store8((bf16_t*)(dst + kimg_off(r, 8 + fq)), k0 * rh, k1 * rh); }
            }
        }
    }
};
struct EpiMulGate {
    const unsigned char* gates; int goff; unsigned char* O;
    __device__ __forceinline__ void operator()(const Acc& acc, const Unit& un, int wr, int wc, int fr, int fq) const {
        const int row0 = un.pm * BM + wr * 64 + fr, c8 = un.pn * BM + wc * 32 + 8 * fq;
#pragma unroll
        for (int ai = 0; ai < 2; ++ai) {
            u32x2 G[4][2];
#pragma unroll
            for (int m = 0; m < 4; ++m) { const size_t r = (size_t)(row0 + ai * HALF + m * 16);
#pragma unroll
                for (int bj = 0; bj < 2; ++bj) G[m][bj] = *(const u32x2*)(gates + r * 2048 + goff + c8 + bj * HALF); }
#pragma unroll
            for (int m = 0; m < 4; ++m) { const size_t r = (size_t)(row0 + ai * HALF + m * 16);
#pragma unroll
                for (int bj = 0; bj < 2; ++bj) { f32x4 g0, g1; unpack8_u8(G[m][bj], g0, g1);
                    *(u32x2*)(O + r * 1024 + c8 + bj * HALF) = pack8_fp8(acc[ai][bj][m][0] * g0, acc[ai][bj][m][1] * g1, MB_SC); } }
        }
    }
};
struct EpiMerge {
    const unsigned char* gates; const unsigned char* mb; bf16_t* O;
    __device__ __forceinline__ void operator()(const Acc& acc, const Unit& un, int wr, int wc, int fr, int fq) const {
        const int row0 = un.pm * BM + wr * 64 + fr, c8 = un.pn * BM + wc * 32 + 8 * fq;
#pragma unroll
        for (int ai = 0; ai < 2; ++ai) {
            u32x2 G[4][2], Y[4][2];
#pragma unroll
            for (int m = 0; m < 4; ++m) { const size_t r = (size_t)(row0 + ai * HALF + m * 16);
#pragma unroll
                for (int bj = 0; bj < 2; ++bj) { G[m][bj] = *(const u32x2*)(gates + r * 2048 + c8 + bj * HALF); Y[m][bj] = *(const u32x2*)(mb + r * 1024 + c8 + bj * HALF); } }
#pragma unroll
            for (int m = 0; m < 4; ++m) { const size_t r = (size_t)(row0 + ai * HALF + m * 16);
#pragma unroll
                for (int bj = 0; bj < 2; ++bj) { f32x4 g0, g1, y0, y1; unpack8_u8(G[m][bj], g0, g1); unpack8_fp8(Y[m][bj], 1.f / MB_SC, y0, y1);
                    store8(O + r * 1024 + c8 + bj * HALF, acc[ai][bj][m][0] * g0 + y0, acc[ai][bj][m][1] * g1 + y1); } }
        }
    }
};
struct EpiQKV {
    EpiPlain q; EpiKV kv;
    __device__ __forceinline__ void operator()(const Acc& acc, const Unit& un, int wr, int wc, int fr, int fq) const {
        if (un.pn < 3) q(acc, un, wr, wc, fr, fq); else { Unit v = un; v.pn = un.pn - 3; kv(acc, v, wr, wc, fr, fq); }
    }
};
struct EpiY {
    EpiMulGate yb; EpiMerge ya;
    __device__ __forceinline__ void operator()(const Acc& acc, const Unit& un, int wr, int wc, int fr, int fq) const {
        if (un.e == 0) yb(acc, un, wr, wc, fr, fq); else ya(acc, un, wr, wc, fr, fq);
    }
};
struct EpiResid {
    const bf16_t* xb; const float* rstd1; bf16_t* x1b;
    __device__ __forceinline__ void operator()(const Acc& acc, const Unit& un, int wr, int wc, int fr, int fq) const {
        const int row0 = un.pm * BM + wr * 64 + fr, c8 = un.pn * BM + wc * 32 + 8 * fq;
#pragma unroll
        for (int ai = 0; ai < 2; ++ai) {
            u32x4 X[4][2]; float iv[4];
#pragma unroll
            for (int m = 0; m < 4; ++m) iv[m] = rstd1[row0 + ai * HALF + m * 16];
#pragma unroll
            for (int m = 0; m < 4; ++m) { const size_t r = (size_t)(row0 + ai * HALF + m * 16);
#pragma unroll
                for (int bj = 0; bj < 2; ++bj) X[m][bj] = *(const u32x4*)(xb + r * 1024 + c8 + bj * HALF); }
#pragma unroll
            for (int m = 0; m < 4; ++m) { const size_t r = (size_t)(row0 + ai * HALF + m * 16);
#pragma unroll
                for (int bj = 0; bj < 2; ++bj) { const u32x4 w = X[m][bj];
                    const f32x4 x0 = (f32x4){bf_lo(w.x), bf_hi(w.x), bf_lo(w.y), bf_hi(w.y)}, x1 = (f32x4){bf_lo(w.z), bf_hi(w.z), bf_lo(w.w), bf_hi(w.w)};
                    const float inv = __builtin_amdgcn_rcpf(iv[m]);
                    store8(x1b + r * 1024 + c8 + bj * HALF, acc[ai][bj][m][0] + x0 * inv, acc[ai][bj][m][1] + x1 * inv); } }
        }
    }
};
struct EpiGU {
    const int* ltok; const float* lw; const float* rstd2; bf16_t* mid;
    __device__ __forceinline__ void operator()(const Acc& acc, const Unit& un, int wr, int wc, int fr, int fq) const {
        const int c8 = un.pn * 128 + wc * 32 + 8 * fq;
        const __amdgpu_buffer_rsrc_t rsrc = __builtin_amdgcn_make_buffer_rsrc((void*)mid, 0, 0x7fffffff, 0x00020000);
        int tk[8]; float w[8], rs[8];
#pragma unroll
        for (int q = 0; q < 8; ++q) { const int rl = (q >> 2) * HALF + wr * 64 + (q & 3) * 16 + fr; const bool valid = rl < un.nv; const size_t li = (size_t)un.e * CAP + un.r0 + rl;
            tk[q] = valid ? ltok[li] : 0; w[q] = valid ? lw[li] : 0.f; }
#pragma unroll
        for (int q = 0; q < 8; ++q) rs[q] = rstd2[tk[q] >> 1];
#pragma unroll
        for (int q = 0; q < 8; ++q) { const int ai = q >> 2, m = q & 3, rl = ai * HALF + wr * 64 + m * 16 + fr;
            f32x4 o[2];
#pragma unroll
            for (int n = 0; n < 2; ++n)
#pragma unroll
                for (int i = 0; i < 4; ++i) { const float a = acc[ai][0][m][n][i] * rs[q], up = acc[ai][1][m][n][i] * rs[q]; o[n][i] = a * sigmoidf_(a) * up * w[q]; }
            u32x4 wv_; wv_.x = cvt_pk_bf16(o[0][0], o[0][1]); wv_.y = cvt_pk_bf16(o[0][2], o[0][3]); wv_.z = cvt_pk_bf16(o[1][0], o[1][1]); wv_.w = cvt_pk_bf16(o[1][2], o[1][3]);
            __builtin_amdgcn_raw_buffer_store_b128(wv_, rsrc, (int)((((unsigned)un.pm * BM + rl) * EFF + c8) * 2u), 0, 16); }
    }
};
struct EpiDown {
    const int* ltok; unsigned char* y;
    __device__ __forceinline__ void operator()(const Acc& acc, const Unit& un, int wr, int wc, int fr, int fq) const {
        const int c8 = un.pn * BM + wc * 32 + 8 * fq;
        int tk[8];
#pragma unroll
        for (int q = 0; q < 8; ++q) { const int rl = (q >> 2) * HALF + wr * 64 + (q & 3) * 16 + fr; tk[q] = rl < un.nv ? ltok[(size_t)un.e * CAP + un.r0 + rl] : -1; }
#pragma unroll
        for (int q = 0; q < 8; ++q) { const int ai = q >> 2, m = q & 3;
            if (tk[q] >= 0) { unsigned char* dst = y + ((size_t)(tk[q] & 1) * NTOK + (tk[q] >> 1)) * DM + c8;
#pragma unroll
                for (int bj = 0; bj < 2; ++bj) *(u32x2*)(dst + bj * HALF) = pack8_fp8(acc[ai][bj][m][0], acc[ai][bj][m][1], Y_SC); } }
    }
};
struct EpiMoe {
    EpiGU gu; EpiDown dn;
    __device__ __forceinline__ void operator()(const Acc& acc, const Unit& un, int wr, int wc, int fr, int fq) const {
        if (un.kind == 0) gu(acc, un, wr, wc, fr, fq); else dn(acc, un, wr, wc, fr, fq);
    }
};
}

namespace att {
constexpr int DQK = 96, DV = 64, NW = 8, QBLK = 32, KVBLK = 64;
constexpr float SCALE = 0.10206207261596575f;
constexpr float THR = 8.f;
constexpr int KSLOT = 12288, VSLOT = 8192, NSLOT = 4, LDS_K = 0, LDS_V = NSLOT * KSLOT, LDS_WS = LDS_V + NSLOT * VSLOT, LDS_W = LDS_WS + NW * 64 * 4, SHM_ATTN = LDS_W + 96 * 512;
#define SBAR() __builtin_amdgcn_sched_barrier(0)
__device__ __forceinline__ int crow(int r, int hi) { return (r & 3) + 8 * (r >> 2) + 4 * hi; }
constexpr float THR2 = 8.f;
__device__ __forceinline__ void partialSM(f32x16& p0, f32x16& p1, float& m_reg, f32x16& negm, float& alpha) {
    float pmax = fmaxf(fmaxf(p0[0], p0[1]), p1[0]);
#pragma unroll
    for (int r = 2; r < 16; ++r) pmax = fmaxf(pmax, p0[r]);
#pragma unroll
    for (int r = 1; r < 16; ++r) pmax = fmaxf(pmax, p1[r]);
    { auto rr = __builtin_amdgcn_permlane32_swap(__float_as_uint(pmax), __float_as_uint(pmax), false, false);
      pmax = fmaxf(__uint_as_float(rr[0]), __uint_as_float(rr[1])); }
    if (__builtin_expect(__all(pmax <= THR2), 1)) { alpha = 1.f; }
    else { const float d = fmaxf(pmax, 0.f); m_reg += d; alpha = __builtin_amdgcn_exp2f(-d);
#pragma unroll
        for (int r = 0; r < 16; ++r) { p0[r] -= d; p1[r] -= d; }
#pragma unroll
        for (int r = 0; r < 16; ++r) negm[r] = -m_reg; }
#pragma unroll
    for (int r = 0; r < 16; ++r) p0[r] = __builtin_amdgcn_exp2f(p0[r]);
}
__device__ __forceinline__ void startSM(f32x16& p0, f32x16& p1, float& m_reg, f32x16& negm) {
    float pmax = fmaxf(fmaxf(p0[0], p0[1]), p1[0]);
#pragma unroll
    for (int r = 2; r < 16; ++r) pmax = fmaxf(pmax, p0[r]);
#pragma unroll
    for (int r = 1; r < 16; ++r) pmax = fmaxf(pmax, p1[r]);
    { auto rr = __builtin_amdgcn_permlane32_swap(__float_as_uint(pmax), __float_as_uint(pmax), false, false);
      pmax = fmaxf(__uint_as_float(rr[0]), __uint_as_float(rr[1])); }
    m_reg = pmax;
#pragma unroll
    for (int r = 0; r < 16; ++r) { p0[r] -= pmax; p1[r] -= pmax; negm[r] = -pmax; }
#pragma unroll
    for (int r = 0; r < 16; ++r) p0[r] = __builtin_amdgcn_exp2f(p0[r]);
}
__device__ __forceinline__ void finishSM(f32x16& p0, f32x16& p1, float alpha, float& l_reg, bf16x8& pa0, bf16x8& pa1, bf16x8& pa2, bf16x8& pa3) {
#pragma unroll
    for (int r = 0; r < 16; ++r) p1[r] = __builtin_amdgcn_exp2f(p1[r]);
    float ps = 0;
#pragma unroll
    for (int r = 0; r < 16; ++r) ps += p0[r];
#pragma unroll
    for (int r = 0; r < 16; ++r) ps += p1[r];
    { auto rr = __builtin_amdgcn_permlane32_swap(__float_as_uint(ps), __float_as_uint(ps), false, false);
      ps = __uint_as_float(rr[0]) + __uint_as_float(rr[1]); }
    l_reg = l_reg * alpha + ps;
#define PK4(P, BASE, OUT) do { unsigned a0 = cvt_pk_bf16(P[BASE + 0], P[BASE + 1]), a1 = cvt_pk_bf16(P[BASE + 2], P[BASE + 3]);   \
    unsigned b0 = cvt_pk_bf16(P[BASE + 4], P[BASE + 5]), b1 = cvt_pk_bf16(P[BASE + 6], P[BASE + 7]);                              \
    auto r0 = __builtin_amdgcn_permlane32_swap(a0, b0, false, false); auto r1 = __builtin_amdgcn_permlane32_swap(a1, b1, false, false); \
    u32x4 w = {r0[0], r1[0], r0[1], r1[1]}; OUT = *reinterpret_cast<bf16x8*>(&w); } while (0)
    PK4(p0, 0, pa0); PK4(p0, 8, pa1); PK4(p1, 0, pa2); PK4(p1, 8, pa3);
#undef PK4
}
__device__ __forceinline__ void qkt(f32x16& p0, f32x16& p1, const char* Ks, const bf16x8* qr, const f32x16& negm, int r32, int hi) {
    const int sw = (r32 >> 2) & 3; const char* kb = Ks + r32 * 192;
#pragma unroll
    for (int d0 = 0; d0 < 6; ++d0) { const int co = ((d0 * 2 + hi) ^ sw) << 4;
        const bf16x8 b0 = *reinterpret_cast<const bf16x8*>(kb + co);
        const bf16x8 b1 = *reinterpret_cast<const bf16x8*>(kb + 32 * 192 + co);
        p0 = __builtin_amdgcn_mfma_f32_32x32x16_bf16(b0, qr[d0], d0 == 0 ? negm : p0, 0, 0, 0);
        p1 = __builtin_amdgcn_mfma_f32_32x32x16_bf16(b1, qr[d0], d0 == 0 ? negm : p1, 0, 0, 0); }
}
__device__ __forceinline__ int v_rd_base(int lane) { return ((lane & 3) << 3) | (((lane >> 2) & 3) << 6) | (((lane >> 4) & 1) << 5) | (((lane >> 5) & 1) << 8); }
constexpr int v_rd_off(int d0, int ks, int half) { return d0 * 512 + ks * 2048 + half * 1024; }
template <int OFF> __device__ __forceinline__ s16x4 tr_read(int vb) {
    s16x4 r; asm volatile("ds_read_b64_tr_b16 %0, %1 offset:%2" : "=&v"(r) : "v"(vb), "i"(OFF) : "memory"); return r;
}
template <int D0> __device__ __forceinline__ void pv_one(f32x16& od, int vb, bf16x8 pa0, bf16x8 pa1, bf16x8 pa2, bf16x8 pa3) {
    const s16x4 l0 = tr_read<v_rd_off(D0, 0, 0)>(vb), h0 = tr_read<v_rd_off(D0, 0, 1)>(vb), l1 = tr_read<v_rd_off(D0, 1, 0)>(vb), h1 = tr_read<v_rd_off(D0, 1, 1)>(vb);
    const s16x4 l2 = tr_read<v_rd_off(D0, 2, 0)>(vb), h2 = tr_read<v_rd_off(D0, 2, 1)>(vb), l3 = tr_read<v_rd_off(D0, 3, 0)>(vb), h3 = tr_read<v_rd_off(D0, 3, 1)>(vb);
    asm volatile("s_waitcnt lgkmcnt(0)" ::: "memory"); SBAR();
#define PK(L, H) (bf16x8){L[0], L[1], L[2], L[3], H[0], H[1], H[2], H[3]}
    od = __builtin_amdgcn_mfma_f32_32x32x16_bf16(pa0, PK(l0, h0), od, 0, 0, 0);
    od = __builtin_amdgcn_mfma_f32_32x32x16_bf16(pa1, PK(l1, h1), od, 0, 0, 0);
    od = __builtin_amdgcn_mfma_f32_32x32x16_bf16(pa2, PK(l2, h2), od, 0, 0, 0);
    od = __builtin_amdgcn_mfma_f32_32x32x16_bf16(pa3, PK(l3, h3), od, 0, 0, 0);
#undef PK
}
__device__ __forceinline__ void pv_d0(f32x16* o, int vb, bf16x8 pa0, bf16x8 pa1, bf16x8 pa2, bf16x8 pa3) {
    pv_one<0>(o[0], vb, pa0, pa1, pa2, pa3); pv_one<1>(o[1], vb, pa0, pa1, pa2, pa3);
}
template <int BASE> __device__ __forceinline__ bf16x8 pk4(const f32x16& P) {
    const unsigned a0 = cvt_pk_bf16(P[BASE + 0], P[BASE + 1]), a1 = cvt_pk_bf16(P[BASE + 2], P[BASE + 3]), b0 = cvt_pk_bf16(P[BASE + 4], P[BASE + 5]), b1 = cvt_pk_bf16(P[BASE + 6], P[BASE + 7]);
    auto r0 = __builtin_amdgcn_permlane32_swap(a0, b0, false, false); auto r1 = __builtin_amdgcn_permlane32_swap(a1, b1, false, false);
    u32x4 w = {r0[0], r1[0], r0[1], r1[1]}; return __builtin_bit_cast(bf16x8, w);
}
__device__ __forceinline__ void attn_unit(const bf16_t* __restrict__ qd, const bf16_t* __restrict__ Wimg, const float* __restrict__ cstab, const float* __restrict__ gq,
                                          const bf16_t* __restrict__ Kimg, const bf16_t* __restrict__ Vimg, bf16_t* __restrict__ Ob, int NT, char* lds, LAS unsigned char* L, const int wave_, const bool first, const bool has_next) {
    const int wid = wave_, lane = lane_id_fresh(), r32 = lane & 31, hi = lane >> 5;
    char* V_lds = lds + LDS_V; char* K_lds = lds + LDS_K;
    float* ws = (float*)(lds + LDS_WS) + wid * 64; float* li_l = ws; float* al_l = ws + 32;
    float m_reg = 0.f, l_reg = 0; f32x16 o[2] = {}; bf16x8 qr[6];
    const int jmax = NT - 4 + (wid >> 1);
    const char* ksrc = (const char*)Kimg + wid * 1024 + lane * 16; const char* vsrc = (const char*)Vimg + wid * 1024 + lane * 16;
#define DMA_TILE(j, slot) do { __builtin_amdgcn_global_load_lds((const unsigned*)(ksrc + (size_t)(j) * KSLOT), (LAS unsigned*)(L + LDS_K + (slot) * KSLOT + wid * 1024), 16, 0, 0); \
        if (wid < 4) __builtin_amdgcn_global_load_lds((const unsigned*)(ksrc + (size_t)(j) * KSLOT + 8192), (LAS unsigned*)(L + LDS_K + (slot) * KSLOT + 8192 + wid * 1024), 16, 0, 0); \
        __builtin_amdgcn_global_load_lds((const unsigned*)(vsrc + (size_t)(j) * VSLOT), (LAS unsigned*)(L + LDS_V + (slot) * VSLOT + wid * 1024), 16, 0, 0); } while (0)
#define WAIT_NEXT() do { if (wid < 4) asm volatile("s_waitcnt vmcnt(3)" ::: "memory"); else asm volatile("s_waitcnt vmcnt(2)" ::: "memory"); } while (0)
#define BAR() do { asm volatile("s_waitcnt lgkmcnt(0)" ::: "memory"); __builtin_amdgcn_s_barrier(); asm volatile("" ::: "memory"); } while (0)
    if (first) {
#pragma unroll
        for (int i = 0; i < 6; ++i) __builtin_amdgcn_global_load_lds((const unsigned*)((const char*)Wimg + (wid + 8 * i) * 1024 + lane * 16), (LAS unsigned*)(L + LDS_W + (wid + 8 * i) * 1024), 16, 0, 0);
        DMA_TILE(0, 0); DMA_TILE(1, 1);
    }
    {
        const int qrow = wid * QBLK + r32;
        const bf16_t* qp = qd + (long)qrow * 512 + hi * 8;
        bf16x8 bq[16]; float ssq = 0.f;
#pragma unroll
        for (int ks = 0; ks < 16; ++ks) bq[ks] = *reinterpret_cast<const bf16x8*>(qp + ks * 16);
#pragma unroll
        for (int ks = 0; ks < 16; ++ks) { const u32x4 w = __builtin_bit_cast(u32x4, bq[ks]);
            const float a0 = bf_lo(w.x), a1 = bf_hi(w.x), a2 = bf_lo(w.y), a3 = bf_hi(w.y), a4 = bf_lo(w.z), a5 = bf_hi(w.z), a6 = bf_lo(w.w), a7 = bf_hi(w.w);
            ssq += (a0 * a0 + a1 * a1) + (a2 * a2 + a3 * a3) + (a4 * a4 + a5 * a5) + (a6 * a6 + a7 * a7); }
        ssq += __shfl_xor(ssq, 32);
        asm volatile("s_waitcnt vmcnt(0)" ::: "memory"); BAR();
        f32x16 qa[3]; qa[0] = f32x16{}; qa[1] = f32x16{}; qa[2] = f32x16{};
        const char* wl = lds + LDS_W + r32 * 512;
#pragma unroll
        for (int ks = 0; ks < 16; ++ks) { const int co = ((2 * ks + hi) ^ r32) << 4;
#pragma unroll
            for (int db = 0; db < 3; ++db) { const bf16x8 a = *reinterpret_cast<const bf16x8*>(wl + db * 32 * 512 + co); qa[db] = __builtin_amdgcn_mfma_f32_32x32x16_bf16(a, bq[ks], qa[db], 0, 0, 0); } }
        const float rq = 1.0f / sqrtf(ssq * (1.f / 256.f) + 1e-6f);
        float ss = 0.f;
#pragma unroll
        for (int db = 0; db < 3; ++db)
#pragma unroll
            for (int r = 0; r < 16; ++r) { qa[db][r] *= rq; ss += qa[db][r] * qa[db][r]; }
        ss += __shfl_xor(ss, 32);
        const float rn = 1.0f / sqrtf(ss * (1.f / 96.f) + 1e-6f);
#pragma unroll
        for (int db = 0; db < 3; ++db)
#pragma unroll
            for (int g4 = 0; g4 < 4; ++g4) { const f32x4 g = *(const f32x4*)(gq + 32 * db + 8 * g4 + 4 * hi);
#pragma unroll
                for (int i = 0; i < 4; ++i) qa[db][4 * g4 + i] *= g[i] * (rn * (SCALE * 1.4426950408889634f)); }
        const float* cs = cstab + (long)qrow * 32 + 4 * hi;
        const f32x4 c0 = *(const f32x4*)cs, c1 = *(const f32x4*)(cs + 8), s0 = *(const f32x4*)(cs + 16), s1 = *(const f32x4*)(cs + 24);
#pragma unroll
        for (int i = 0; i < 4; ++i) {
            const float xa = qa[2][i], xb_ = qa[2][8 + i], ya = qa[2][4 + i], yb = qa[2][12 + i];
            qa[2][i] = xa * c0[i] - xb_ * s0[i]; qa[2][8 + i] = xb_ * c0[i] + xa * s0[i];
            qa[2][4 + i] = ya * c1[i] - yb * s1[i]; qa[2][12 + i] = yb * c1[i] + ya * s1[i]; }
        qr[0] = pk4<0>(qa[0]); qr[1] = pk4<8>(qa[0]); qr[2] = pk4<0>(qa[1]); qr[3] = pk4<8>(qa[1]); qr[4] = pk4<0>(qa[2]); qr[5] = pk4<8>(qa[2]);
    }
    const int vb0 = (int)(uintptr_t)V_lds + v_rd_base(lane);
#define RESC(a) do { if (__any((a) < 1.f)) { if (hi == 0) al_l[r32] = (a); asm volatile("s_waitcnt lgkmcnt(0)" ::: "memory"); \
    _Pragma("unroll") for (int d = 0; d < 2; ++d) _Pragma("unroll") for (int r = 0; r < 16; ++r) o[d][r] *= al_l[crow(r, hi)]; } } while (0)
    f32x16 pA0, pA1, pB0, pB1; float alA = 1.f, alB = 1.f; bf16x8 pa0, pa1, pa2, pa3; f32x16 negm = f32x16{};
    WAIT_NEXT(); BAR(); DMA_TILE(2, 2);
    qkt(pA0, pA1, K_lds, qr, negm, r32, hi); startSM(pA0, pA1, m_reg, negm);
    for (int t = 1; t + 1 < NT; t += 2) {
        WAIT_NEXT(); BAR(); DMA_TILE(t + 2, (t + 2) & 3);
        if (t - 1 <= jmax) {
            SBAR(); if (t <= jmax) qkt(pB0, pB1, K_lds + (t & 3) * KSLOT, qr, negm, r32, hi);
            finishSM(pA0, pA1, alA, l_reg, pa0, pa1, pa2, pa3); SBAR();
            pv_d0(o, vb0 + ((t - 1) & 3) * VSLOT, pa0, pa1, pa2, pa3);
            if (t <= jmax) { partialSM(pB0, pB1, m_reg, negm, alB); RESC(alB); }
        }
        WAIT_NEXT(); BAR(); if (t + 3 < NT) DMA_TILE(t + 3, (t + 3) & 3);
        if (t <= jmax) {
            SBAR(); if (t + 1 <= jmax) qkt(pA0, pA1, K_lds + ((t + 1) & 3) * KSLOT, qr, negm, r32, hi);
            finishSM(pB0, pB1, alB, l_reg, pa0, pa1, pa2, pa3); SBAR();
            pv_d0(o, vb0 + (t & 3) * VSLOT, pa0, pa1, pa2, pa3);
            if (t + 1 <= jmax) { partialSM(pA0, pA1, m_reg, negm, alA); RESC(alA); }
        }
    }
    asm volatile("s_waitcnt vmcnt(0)" ::: "memory"); BAR();
    if (has_next) { DMA_TILE(0, 0); DMA_TILE(1, 1); }
    if (NT - 2 <= jmax) {
        SBAR(); if (NT - 1 <= jmax) qkt(pB0, pB1, K_lds + ((NT - 1) & 3) * KSLOT, qr, negm, r32, hi);
        finishSM(pA0, pA1, alA, l_reg, pa0, pa1, pa2, pa3); SBAR();
        pv_d0(o, vb0 + ((NT - 2) & 3) * VSLOT, pa0, pa1, pa2, pa3);
        if (NT - 1 <= jmax) { partialSM(pB0, pB1, m_reg, negm, alB); RESC(alB);
            finishSM(pB0, pB1, alB, l_reg, pa0, pa1, pa2, pa3); SBAR();
            pv_d0(o, vb0 + ((NT - 1) & 3) * VSLOT, pa0, pa1, pa2, pa3); }
    }
    if (hi == 0) li_l[r32] = l_reg; asm volatile("s_waitcnt lgkmcnt(0)" ::: "memory");
    float rli[16];
#pragma unroll
    for (int r = 0; r < 16; ++r) rli[r] = __builtin_amdgcn_rcpf(li_l[crow(r, hi)]);
    bf16_t* Ow = Ob + (long)(wid * QBLK) * 512;
#pragma unroll
    for (int r = 0; r < 16; ++r) { const int orow = crow(r, hi);
#pragma unroll
        for (int d0 = 0; d0 < 2; ++d0) Ow[(long)orow * 512 + d0 * 32 + r32] = (bf16_t)(cvt_pk_bf16(o[d0][r] * rli[r], 0.f) & 0xffffu); }
    if (!has_next) BAR();
#undef DMA_TILE
#undef WAIT_NEXT
#undef BAR
#undef RESC
}
#undef SBAR
}

__device__ __forceinline__ void tr_item(const float* W, int ldw, int src_col, bf16_t* WT, int ldk, int dst_row, int k0, const float* gain, LAS float* scr, int lane) {
    const int c = lane & 7;
    if (src_col < 0) {
#pragma unroll
        for (int j = 0; j < 4; ++j) { const int n = (lane >> 3) + 8 * j; *(u32x4*)(WT + (size_t)(dst_row + n) * ldk + k0 + 8 * c) = (u32x4){0u, 0u, 0u, 0u}; }
        return;
    }
    f32x4 v[8];
#pragma unroll
    for (int j = 0; j < 8; ++j) v[j] = *(const f32x4*)(W + (size_t)(k0 + (lane >> 3) + 8 * j) * ldw + src_col + 4 * c);
    if (gain) {
#pragma unroll
        for (int j = 0; j < 8; ++j) v[j] = v[j] * gain[k0 + (lane >> 3) + 8 * j];
    }
#pragma unroll
    for (int j = 0; j < 8; ++j) { LAS float* d = scr + ((lane >> 3) + 8 * j) * 33 + 4 * c; d[0] = v[j][0]; d[1] = v[j][1]; d[2] = v[j][2]; d[3] = v[j][3]; }
    LDS_WAIT(); asm volatile("" ::: "memory");
#pragma unroll
    for (int j = 0; j < 4; ++j) { const int n = (lane >> 3) + 8 * j; const LAS float* s = scr + (8 * c) * 33 + n;
        u32x4 o; o.x = cvt_pk_bf16(s[0 * 33], s[1 * 33]); o.y = cvt_pk_bf16(s[2 * 33], s[3 * 33]); o.z = cvt_pk_bf16(s[4 * 33], s[5 * 33]); o.w = cvt_pk_bf16(s[6 * 33], s[7 * 33]);
        *(u32x4*)(WT + (size_t)(dst_row + n) * ldk + k0 + 8 * c) = o; }
    LDS_WAIT(); asm volatile("" ::: "memory");
}

__device__ __forceinline__ void tr_item8(const float* W, int ldw, int src_col, unsigned char* WT8, int ldk, int dst_row, int k0, const float* gain, float sc, LAS float* scr, int lane) {
    const int c = lane & 7;
    f32x4 v[8];
#pragma unroll
    for (int j = 0; j < 8; ++j) v[j] = *(const f32x4*)(W + (size_t)(k0 + (lane >> 3) + 8 * j) * ldw + src_col + 4 * c);
#pragma unroll
    for (int j = 0; j < 8; ++j) v[j] = v[j] * (gain[k0 + (lane >> 3) + 8 * j] * sc);
#pragma unroll
    for (int j = 0; j < 8; ++j) { LAS float* d = scr + ((lane >> 3) + 8 * j) * 33 + 4 * c; d[0] = v[j][0]; d[1] = v[j][1]; d[2] = v[j][2]; d[3] = v[j][3]; }
    LDS_WAIT(); asm volatile("" ::: "memory");
    const int c4 = lane & 3;
#pragma unroll
    for (int j = 0; j < 2; ++j) { const int n = (lane >> 2) + 16 * j; const LAS float* s = scr + (16 * c4) * 33 + n;
        const u32x2 lo = pack8_fp8((f32x4){s[0 * 33], s[1 * 33], s[2 * 33], s[3 * 33]}, (f32x4){s[4 * 33], s[5 * 33], s[6 * 33], s[7 * 33]}, 1.f);
        const u32x2 hi = pack8_fp8((f32x4){s[8 * 33], s[9 * 33], s[10 * 33], s[11 * 33]}, (f32x4){s[12 * 33], s[13 * 33], s[14 * 33], s[15 * 33]}, 1.f);
        *(u32x4*)(WT8 + (size_t)(dst_row + n) * ldk + k0 + 16 * c4) = (u32x4){lo.x, lo.y, hi.x, hi.y}; }
    LDS_WAIT(); asm volatile("" ::: "memory");
}

#ifndef DBG_STOP
#define DBG_STOP 0
#endif
constexpr size_t WS_DBG = 448 * MiB;
struct Args { const void* in[26]; float* out; unsigned char* ws; int mask, pad; };

__global__ void __launch_bounds__(NTHR, 2) mk_fwd(Args args) {
    extern __shared__ __attribute__((aligned(16))) unsigned char lds[];
    LAS unsigned char* L = (LAS unsigned char*)lds;
    volatile LAS unsigned* MISC = (volatile LAS unsigned*)(L + MISC_OFF);
    const int wave = __builtin_amdgcn_readfirstlane((int)threadIdx.x >> 6);
    const int G = gridDim.x, bx = blockIdx.x;
    const int gw = bx * NWAVES + wave, NGW = G * NWAVES;
    unsigned char* ws = args.ws;
    const float* x = (const float*)args.in[0]; const int* positions = (const int*)args.in[1];
    const float* g_mix = (const float*)args.in[2]; const float* w_in = (const float*)args.in[3];
    const float* g_q_lora = (const float*)args.in[4]; const float* w_uq = (const float*)args.in[5];
    const float* g_kv_lora = (const float*)args.in[6]; const float* w_ukv = (const float*)args.in[7];
    const float* g_qk_q = (const float*)args.in[8]; const float* g_qk_k = (const float*)args.in[9];
    const float* w_o_mla = (const float*)args.in[10]; const float* w_dw = (const float*)args.in[11]; const float* b_dw = (const float*)args.in[12];
    const float* g_conv_ln = (const float*)args.in[13]; const float* b_conv_ln = (const float*)args.in[14]; const float* w_conv_out = (const float*)args.in[15];
    const float* b_gates = (const float*)args.in[16]; const float* w_out = (const float*)args.in[17]; const float* g_ffn = (const float*)args.in[18];
    const float* w_gr = (const float*)args.in[19]; const float* b_gr = (const float*)args.in[20]; const float* w_er = (const float*)args.in[21]; const float* b_er = (const float*)args.in[22];
    const float* w_eg = (const float*)args.in[23]; const float* w_eu = (const float*)args.in[24]; const float* w_ed = (const float*)args.in[25];
    float* out = args.out;
    unsigned* ctl = (unsigned*)(ws + WS_CTL);
    float* rstd2 = (float*)(ws + WS_RSTD2);
    bf16_t* WrB = (bf16_t*)(ws + WS_WRB);
    bf16_t* Wt_in = (bf16_t*)(ws + WS_WIN); bf16_t* Wq_img = (bf16_t*)(ws + WS_WQIMG); bf16_t* Wt_ukv = (bf16_t*)(ws + WS_WUKV); float* rstd1 = (float*)(ws + WS_RSTD1);
    bf16_t* Wt_o = (bf16_t*)(ws + WS_WO); bf16_t* Wt_c = (bf16_t*)(ws + WS_WC); bf16_t* Wt_out = (bf16_t*)(ws + WS_WOUT);
    bf16_t* Wt_gu = (bf16_t*)(ws + WS_WGU); bf16_t* Wt_d = (bf16_t*)(ws + WS_WD);
    bf16_t* xb = (bf16_t*)(ws + WS_A); bf16_t* attn = (bf16_t*)(ws + WS_T + 16 * MiB); bf16_t* x1b = (bf16_t*)(ws + WS_G);
    bf16_t* qkvd = (bf16_t*)(ws + WS_B); bf16_t* ubuf = (bf16_t*)(ws + WS_B + 32 * MiB); unsigned char* mb = (unsigned char*)(ws + WS_B);
    int* ltok = (int*)(ws + WS_B); float* lw = (float*)(ws + WS_B + 4 * MiB); bf16_t* mid = (bf16_t*)(ws + WS_B + 8 * MiB);
    bf16_t* Vg = (bf16_t*)(ws + WS_C); bf16_t* merged = (bf16_t*)(ws + WS_C);
    bf16_t* ub = (bf16_t*)(ws + WS_D); unsigned char* ybuf = (unsigned char*)(ws + WS_D);
    bf16_t* Kg = (bf16_t*)(ws + WS_E);
    float* cstab = (float*)(ws + WS_T); bf16_t* krr = (bf16_t*)(ws + WS_T + 4 * MiB);
    float* ssq_kv = (float*)(ws + WS_T + 8 * MiB); float* ssq_rope = ssq_kv + 4 * NTOK;
    unsigned char* xb8 = ws + WS_XB8; unsigned char* Wt_in8 = ws + WS_XB8 + 32 * MiB;
    unsigned char* gates = (unsigned char*)(ws + WS_G);
    unsigned* gcnt = ctl + CW_CNT;

    { const int tid = wave * 64 + lane_id_fresh(); for (int u = tid; u < 1024; u += NTHR) MISC[u] = 0u; }
    __syncthreads();
    XcdBarrier bar = xcd_barrier_post(ctl + CW_BAR, MISC + 8);
#ifndef USE_CG
#define USE_CG 0
#endif
#if USE_CG
    cooperative_groups::grid_group cg_grid = cooperative_groups::this_grid();
#define GRID_BAR() do { __threadfence(); cg_grid.sync(); } while (0)
#else
#define GRID_BAR() xcd_barrier(bar)
#endif
#define DBG_FINISH() do { GRID_BAR(); { const int tid_ = wave * 64 + lane_id_fresh(); const bf16_t* dbg_ = (const bf16_t*)(ws + WS_DBG); \
        for (size_t i = (size_t)bx * NTHR + tid_; i < (size_t)NTOK * DM / 8; i += (size_t)G * NTHR) { f32x4 a0, a1; load8(dbg_ + i * 8, a0, a1); f32x4* o = (f32x4*)(out + i * 8); o[0] = a0; o[1] = a1; } } return; } while (0)
#define DBG_PROBE(expr) do { GRID_BAR(); { const int tid_ = wave * 64 + lane_id_fresh(); bf16_t* dbg_ = (bf16_t*)(ws + WS_DBG); \
        for (size_t i = (size_t)bx * NTHR + tid_; i < (size_t)NTOK * DM; i += (size_t)G * NTHR) { const size_t t = i >> 10; const int c = (int)(i & 1023); (void)t; (void)c; \
            const float v = (expr); dbg_[i] = (bf16_t)(cvt_pk_bf16(v, 0.f) & 0xffffu); } } DBG_FINISH(); } while (0)

    if (args.mask & (1 << 0)) {
    {
        const int lane = lane_id_fresh(), tid = wave * 64 + lane; (void)tid; (void)lane;
        LAS float* scr = (LAS float*)(L + wave * 16384);
        constexpr int I_IN8 = 64 * 16;
        constexpr int I_IN = 48 * 16, I_UQ = 24 * 4, I_UKV = 32 * 2, I_O = 32 * 8, I_C = 32 * 8, I_OUT = 32 * 16, I_GU = 32 * 16 * 16, I_D = 32 * 32 * 4;
        constexpr int NITEMS = I_IN + I_UQ + I_UKV + I_O + I_C + I_OUT + I_GU + I_D + I_IN8;
        for (int it = gw; it < NITEMS; it += NGW) {
            int r = it;
            if (r < I_IN) { const int rg = r / 16, kb = r % 16, row = rg * 32; int src;
                if (row < 416) src = row; else if (row < 512) src = -1;
                else if (row < 1536) { const int t = (row - 512) / 256, rr = (row - 512) % 256; src = rr < 128 ? 416 + 128 * t + rr : 416 + 512 + 128 * t + (rr - 128); }
                else src = 1440 + (row - 1536);
                tr_item(w_in, INC, src, Wt_in, 1024, row, kb * 64, g_mix, scr, lane); continue; } r -= I_IN;
            if (r < I_UQ) { continue; } r -= I_UQ;
            if (r < I_UKV) { const int rg = r / 2, kb = r % 2, pn_ = rg / 8, q_ = rg % 8, bj_ = q_ / 4, wc_ = q_ % 4;
                const int srcc = (2 * pn_ + (wc_ & 1)) * 128 + (wc_ >> 1) * 64 + 32 * bj_;
                tr_item(w_ukv, 1024, srcc, Wt_ukv, 128, rg * 32, kb * 64, g_kv_lora, scr, lane); continue; } r -= I_UKV;
            if (r < I_O) { const int rg = r / 8, kb = r % 8; tr_item(w_o_mla, 1024, rg * 32, Wt_o, 512, rg * 32, kb * 64, nullptr, scr, lane); continue; } r -= I_O;
            if (r < I_C) { const int rg = r / 8, kb = r % 8; tr_item(w_conv_out, 1024, rg * 32, Wt_c, 512, rg * 32, kb * 64, nullptr, scr, lane); continue; } r -= I_C;
            if (r < I_OUT) { const int rg = r / 16, kb = r % 16; tr_item(w_out, 1024, rg * 32, Wt_out, 1024, rg * 32, kb * 64, nullptr, scr, lane); continue; } r -= I_OUT;
            if (r < I_GU) { const int e = r / 256, q = r % 256, rg = q / 16, kb = q % 16, row = rg * 32, pn = row / 256, rr = row % 256;
                const float* src = (rr < 128 ? w_eg : w_eu) + (size_t)e * 1024 * 256; const int sc = 128 * pn + (rr & 127);
                tr_item(src, 256, sc, Wt_gu + (size_t)e * 512 * 1024, 1024, row, kb * 64, g_ffn, scr, lane); continue; } r -= I_GU;
            if (r < I_D) { const int e = r / 128, q = r % 128, rg = q / 4, kb = q % 4;
              tr_item(w_ed + (size_t)e * 256 * 1024, 1024, rg * 32, Wt_d + (size_t)e * 1024 * 256, 256, rg * 32, kb * 64, nullptr, scr, lane); continue; } r -= I_D;
            { const int rg = r / 16, kb = r % 16; tr_item8(w_in, INC, 1440 + rg * 32, Wt_in8, 1024, rg * 32, kb * 64, g_mix, 16.f, scr, lane); }
        }
        for (int p = bx * NTHR + tid; p < 2 * 16 * 3 * 64 * 8; p += G * NTHR) {
            const int j = p & 7, ln = (p >> 3) & 63, q = p >> 9, cf = q % 3, ks = (q / 3) % 16, kh = q / 48;
            const int k = kh * 512 + ks * 32 + 8 * (ln >> 4) + j, col = 16 * cf + (ln & 15);
            float w = 0.f; if (col < 4) w = w_gr[k * 4 + col]; else if (col < 36) w = w_er[k * 32 + (col - 4)];
            w *= g_ffn[k];
            const unsigned hb = cvt_pk_bf16(w, 0.f) & 0xffffu; const float lo = w - __uint_as_float(hb << 16);
            const unsigned lb = cvt_pk_bf16(lo, 0.f) & 0xffffu;
            const size_t base = ((size_t)((kh * 16 + ks) * 3 + cf) * 2) * 512 + ln * 8 + j;
            WrB[base] = (bf16_t)hb; WrB[base + 512] = (bf16_t)lb;
        }
        if (bx == 0 && tid < 32) gcnt[tid] = 0u;
        if (bx == 0 && tid < 320) ctl[CW_TCNT + tid] = 0u;
        for (int p = bx * NTHR + tid; p < 768 * 32; p += G * NTHR) {
            const int row = p >> 5, ch = p & 31, d = row % 96; float v[8];
#pragma unroll
            for (int j = 0; j < 8; ++j) v[j] = w_uq[(size_t)(8 * ch + j) * 768 + row] * g_q_lora[8 * ch + j];
            u32x4 o; o.x = cvt_pk_bf16(v[0], v[1]); o.y = cvt_pk_bf16(v[2], v[3]); o.z = cvt_pk_bf16(v[4], v[5]); o.w = cvt_pk_bf16(v[6], v[7]);
            *(u32x4*)(Wq_img + (size_t)row * 256 + ((ch ^ (d & 31)) << 3)) = o; }
        for (int p = bx * NTHR + tid; p < NTOK * 16; p += G * NTHR) {
            const int t = p >> 4, i = p & 15; const float invf = exp2f(-(float)i * (13.287712379549449f / 16.f));
            float sn, cs; sincosf((float)positions[t] * invf, &sn, &cs); cstab[t * 32 + i] = cs; cstab[t * 32 + 16 + i] = sn; }
        for (int m = gw; m < NTOK; m += 2 * NGW) {
            const int m2 = m + NGW;
            const f32x4* xr = (const f32x4*)(x + (size_t)m * DM) + lane; const f32x4* xr2 = (const f32x4*)(x + (size_t)(m2 < NTOK ? m2 : m) * DM) + lane;
            f32x4 v[4], w[4]; float s = 0.f, s2 = 0.f;
#pragma unroll
            for (int j = 0; j < 4; ++j) { v[j] = xr[64 * j]; w[j] = xr2[64 * j]; }
#pragma unroll
            for (int j = 0; j < 4; ++j) { s += (v[j][0] * v[j][0] + v[j][1] * v[j][1]) + (v[j][2] * v[j][2] + v[j][3] * v[j][3]); s2 += (w[j][0] * w[j][0] + w[j][1] * w[j][1]) + (w[j][2] * w[j][2] + w[j][3] * w[j][3]); }
            const float rs = 1.0f / sqrtf(wave_sum(s) * (1.f / DM) + EPS), rs2 = 1.0f / sqrtf(wave_sum(s2) * (1.f / DM) + EPS);
            u32x2* o8 = (u32x2*)(xb + (size_t)m * DM) + lane;
#pragma unroll
            for (int j = 0; j < 4; ++j) { u32x2 q; q.x = cvt_pk_bf16(v[j][0] * rs, v[j][1] * rs); q.y = cvt_pk_bf16(v[j][2] * rs, v[j][3] * rs); o8[64 * j] = q;
                int w8 = 0; w8 = __builtin_amdgcn_cvt_pk_fp8_f32(v[j][0] * rs, v[j][1] * rs, w8, false); w8 = __builtin_amdgcn_cvt_pk_fp8_f32(v[j][2] * rs, v[j][3] * rs, w8, true); ((int*)(xb8 + (size_t)m * DM))[lane + 64 * j] = w8; }
            if (lane == 0) { rstd1[m] = rs; if (m2 < NTOK) rstd1[m2] = rs2; }
            if (m2 < NTOK) { u32x2* o9 = (u32x2*)(xb + (size_t)m2 * DM) + lane;
#pragma unroll
                for (int j = 0; j < 4; ++j) { u32x2 q; q.x = cvt_pk_bf16(w[j][0] * rs2, w[j][1] * rs2); q.y = cvt_pk_bf16(w[j][2] * rs2, w[j][3] * rs2); o9[64 * j] = q;
                    int w8 = 0; w8 = __builtin_amdgcn_cvt_pk_fp8_f32(w[j][0] * rs2, w[j][1] * rs2, w8, false); w8 = __builtin_amdgcn_cvt_pk_fp8_f32(w[j][2] * rs2, w[j][3] * rs2, w8, true); ((int*)(xb8 + (size_t)m2 * DM))[lane + 64 * j] = w8; } }
        }
    }
    if (args.mask & ~(1 << 0)) GRID_BAR();
    }

    if (args.mask & (1 << 1)) {
    {
        { pg8::DenseSched S; S.init(xb, 1024, Wt_in, 1024, NTOK, 1536, G, bx); S.ntk = 16;
          pg8::EpiG1 E{qkvd, ubuf, gates, b_gates, rstd1, ssq_kv, ssq_rope, krr, cstab, g_qk_k};
          pg8::gemm_phase<pg8::EpiG1, pg8::DenseSched, true>(L, wave, 1024, S, E); }
        { pg8::DenseSched S; S.init((const bf16_t*)xb8, 512, (const bf16_t*)Wt_in8, 512, NTOK, 2048, G, bx); S.ntk = 8;
          pg8::EpiGates E{gates, b_gates};
          pg8::gemm_phase<pg8::EpiGates, pg8::DenseSched, true, true>(L, wave, 1024, S, E); }
    }
    if (args.mask & ~(1 << 1)) GRID_BAR();
    }

    if (args.mask & (1 << 2)) {
    {
        { pg8::DenseSched S; S.init(qkvd + 256, 512, Wt_ukv, 128, NTOK, 1024, G, bx); S.ntk = 2; pg8::EpiKV E{ssq_kv, ssq_rope, krr, g_qk_k, Kg, Vg};
          pg8::gemm_phase<pg8::EpiKV, pg8::DenseSched, true>(L, wave, 128, S, E); }
        const int lane = lane_id_fresh(), tid = wave * 64 + lane;
#define LBAR() do { asm volatile("s_waitcnt lgkmcnt(0)" ::: "memory"); __builtin_amdgcn_s_barrier(); asm volatile("" ::: "memory"); } while (0)
        LAS float* red = (LAS float*)(L + 131072);
        const int c2 = tid & 255, th = tid >> 8, wq = wave & 3;
        h16x2 wv[CONVK];
#pragma unroll
        for (int k = 0; k < CONVK; ++k) wv[k] = (h16x2){(_Float16)w_dw[k * CONVW + 2 * c2], (_Float16)w_dw[k * CONVW + 2 * c2 + 1]};
        const h16x2 bd = {(_Float16)b_dw[2 * c2], (_Float16)b_dw[2 * c2 + 1]};
        const float lg0 = g_conv_ln[2 * c2], lg1 = g_conv_ln[2 * c2 + 1], lb0 = b_conv_ln[2 * c2], lb1 = b_conv_ln[2 * c2 + 1];
        constexpr int NTILE = NBATCH * (SEQ / 32);
#define CONV_DMA(tile_, buf_) do { const int b_ = (tile_) / (SEQ / 32), t0_ = ((tile_) % (SEQ / 32)) * 32; const char* src_ = (const char*)(ubuf + ((long)b_ * SEQ + t0_ - 30) * CONVW) + lane * 16; \
            _Pragma("unroll") for (int i = 0; i < 8; ++i) __builtin_amdgcn_global_load_lds((const unsigned*)(src_ + (long)(wave + 8 * i) * 1024), (LAS unsigned*)(L + (buf_) * 65536 + (wave + 8 * i) * 1024), 16, 0, 0); } while (0)
        const int nper = (NTILE + G - 1) / G, tile_end = (bx * nper + nper < NTILE) ? bx * nper + nper : NTILE;
        LBAR();
        if (bx * nper < NTILE) CONV_DMA(bx * nper, 0);
        asm volatile("s_waitcnt vmcnt(0)" ::: "memory");
        int it = 0; unsigned yst[16]; size_t prow = 0;
#pragma unroll
        for (int o = 0; o < 16; ++o) yst[o] = 0u;
#pragma unroll 1
        for (int tile = bx * nper; tile < tile_end; ++tile, ++it) {
            const int b = tile / (SEQ / 32), t0 = (tile % (SEQ / 32)) * 32, buf = it & 1; const size_t rowbase = (size_t)b * SEQ + t0;
            asm volatile("s_waitcnt vmcnt(0)" ::: "memory");
            LBAR();
            if (it) {
#pragma unroll
                for (int o = 0; o < 16; ++o) *(unsigned*)(ub + (prow + o) * CONVW + 2 * c2) = yst[o]; }
            if (tile + 1 < tile_end) CONV_DMA(tile + 1, buf ^ 1);
            LAS bf16_t* uS = (LAS bf16_t*)(L + buf * 65536);
            if (t0 == 0) {
                for (int idx = tid; idx < 30 * 64; idx += NTHR) *(LAS u32x4*)(uS + idx * 8) = (u32x4){0u, 0u, 0u, 0u};
                LBAR();
            }
            h16x2 ah[16];
#pragma unroll
            for (int o = 0; o < 16; ++o) ah[o] = bd;
#pragma unroll
            for (int j = 0; j < 46; ++j) { const h16x2 xv = *(const LAS h16x2*)(uS + (th * 16 + j) * CONVW + 2 * c2);
#pragma unroll
                for (int o = 0; o < 16; ++o) { const int k = j - o; if (k >= 0 && k < CONVK) ah[o] = __builtin_elementwise_fma(wv[k], xv, ah[o]); } }
            float a0[16], a1[16];
#pragma unroll
            for (int o = 0; o < 16; ++o) { a0[o] = (float)ah[o][0]; a1[o] = (float)ah[o][1]; }
            float v16[16], v8[8];
#pragma unroll
            for (int o = 0; o < 16; ++o) { const float sv = a0[o] + a1[o], qv = a0[o] * a0[o] + a1[o] * a1[o];
                auto r = __builtin_amdgcn_permlane32_swap(__float_as_uint(sv), __float_as_uint(qv), false, false); v16[o] = __uint_as_float(r[0]) + __uint_as_float(r[1]); }
#pragma unroll
            for (int t = 0; t < 8; ++t) { auto r = __builtin_amdgcn_permlane16_swap(__float_as_uint(v16[t]), __float_as_uint(v16[8 + t]), false, false); v8[t] = __uint_as_float(r[0]) + __uint_as_float(r[1]); }
#define DPP_ADD(v, ctrl) v += __uint_as_float((unsigned)__builtin_amdgcn_update_dpp(0, (int)__float_as_uint(v), ctrl, 0xF, 0xF, true))
#pragma unroll
            for (int t = 0; t < 8; ++t) { DPP_ADD(v8[t], 0xB1); DPP_ADD(v8[t], 0x4E); DPP_ADD(v8[t], 0x141); DPP_ADD(v8[t], 0x140); }
#undef DPP_ADD
            { const int l16 = lane & 15; float sel = v8[0];
#pragma unroll
              for (int t = 1; t < 8; ++t) sel = (l16 == t) ? v8[t] : sel;
              if (l16 < 8) red[((th * 16 + 8 * ((lane >> 4) & 1) + l16) * 2 + (lane >> 5)) * 4 + wq] = sel; }
            LBAR();
#pragma unroll
            for (int o = 0; o < 16; ++o) { const f32x4 s4 = *(const LAS f32x4*)(red + (th * 16 + o) * 8), q4 = *(const LAS f32x4*)(red + (th * 16 + o) * 8 + 4);
                const float mean = ((s4[0] + s4[1]) + (s4[2] + s4[3])) * (1.f / CONVW);
                const float var = fmaxf(((q4[0] + q4[1]) + (q4[2] + q4[3])) * (1.f / CONVW) - mean * mean, 0.f);
                const float rs = __builtin_amdgcn_rsqf(var + EPS);
                const float A0 = rs * lg0, A1 = rs * lg1;
                float y0 = fmaf(a0[o], A0, fmaf(-mean, A0, lb0)), y1 = fmaf(a1[o], A1, fmaf(-mean, A1, lb1));
                y0 *= sigmoidf_(y0); y1 *= sigmoidf_(y1);
                yst[o] = cvt_pk_bf16(y0, y1); }
            prow = rowbase + th * 16;
        }
        if (it) {
#pragma unroll
            for (int o = 0; o < 16; ++o) *(unsigned*)(ub + (prow + o) * CONVW + 2 * c2) = yst[o]; }
#undef CONV_DMA
#undef LBAR
        asm volatile("s_waitcnt vmcnt(0)" ::: "memory");
        __syncthreads();
    }
    if (args.mask & ~(1 << 2)) GRID_BAR();
    }

    if (args.mask & ((1 << 4) | (1 << 11))) {
    {
        const int vcu = (G % 8 == 0) ? (bx % 8) * (G / 8) + bx / 8 : bx;
        if (args.mask & (1 << 4)) for (int uu = vcu; uu < 2 * NBATCH * NH; uu += G) {
            const int bh = uu >> 1, half = uu & 1;
#pragma unroll 1
            for (int i = 0; i < 4; ++i) { const int s = half * 2 + (i >> 1), qb = (i & 1) ? 7 - s : s;
                const int b = bh / NH, h = bh % NH;
                const size_t tok0 = (size_t)b * SEQ + qb * 256;
                att::attn_unit(qkvd + tok0 * 512, Wq_img + (size_t)h * 96 * 256, cstab + tok0 * 32, g_qk_q, Kg + (size_t)bh * SEQ * 96, Vg + (size_t)bh * SEQ * 64,
                               attn + tok0 * 512 + h * 64, 4 * qb + 4, (char*)lds, L, wave, i == 0, i < 3); }
        }
        __syncthreads();
    }
    if (args.mask & ~((1 << 4) | (1 << 11))) GRID_BAR();
    }

    if (args.mask & (1 << 5)) {
    {
        pg8::YSched S; S.Ab = ub; S.Aa = attn; S.Bb = Wt_c; S.Ba = Wt_o; S.lda = 512; S.ldb = 512; S.G = G; S.c = bx; S.nper = (512 + G - 1) / G;
        pg8::EpiY E{pg8::EpiMulGate{gates, 1024, mb}, pg8::EpiMerge{gates, mb, merged}};
        pg8::gemm_phase<pg8::EpiY, pg8::YSched, true>(L, wave, 512, S, E);
    }
    if (args.mask & ~(1 << 5)) GRID_BAR();
    }

    if (args.mask & (1 << 6)) {
    {
        pg8::DenseSched S; S.init(merged, 1024, Wt_out, 1024, NTOK, 1024, G, bx); S.ntk = 16; pg8::EpiResid E{xb, rstd1, x1b};
        pg8::gemm_phase<pg8::EpiResid, pg8::DenseSched, true>(L, wave, 1024, S, E);
    }
    if (args.mask & ~(1 << 6)) GRID_BAR();
    }

    if (args.mask & (1 << 7)) {
    {
        const int lane = lane_id_fresh(), tid = wave * 64 + lane; (void)tid; (void)lane;
        LAS unsigned* lcnt = (LAS unsigned*)(L + MISC_OFF + 256); LAS unsigned* lbase = (LAS unsigned*)(L + MISC_OFF + 512);
        for (int rb = bx; rb < NTOK / 128; rb += G) {
            f32x4 acc[3]; acc[0] = acc[1] = acc[2] = (f32x4){0.f, 0.f, 0.f, 0.f}; float ssq = 0.f;
            const int row = rb * 128 + wave * 16 + (lane & 15);
            const bf16_t* xr = x1b + (size_t)row * DM + 8 * (lane >> 4);
            if (tid < 32) lcnt[tid] = 0u;
#pragma unroll 1
            for (int kh = 0; kh < 2; ++kh) {
                __syncthreads();
#pragma unroll
                for (int i = 0; i < 12; ++i) { const int idx = i * NTHR + tid; ((LAS u32x4*)L)[idx] = ((const u32x4*)(WrB + (size_t)kh * 49152))[idx]; }
                __syncthreads();
#pragma unroll 4
                for (int ks = 0; ks < 16; ++ks) {
                    const u32x4 hw = *(const u32x4*)(xr + kh * 512 + ks * 32);
                    { const float a0 = bf_lo(hw.x), a1 = bf_hi(hw.x), a2 = bf_lo(hw.y), a3 = bf_hi(hw.y), a4 = bf_lo(hw.z), a5 = bf_hi(hw.z), a6 = bf_lo(hw.w), a7 = bf_hi(hw.w);
                      ssq += (a0 * a0 + a1 * a1) + (a2 * a2 + a3 * a3) + (a4 * a4 + a5 * a5) + (a6 * a6 + a7 * a7); }
                    const bf16x8 ah = __builtin_bit_cast(bf16x8, hw);
#pragma unroll
                    for (int cf = 0; cf < 3; ++cf) {
                        const bf16x8 bh = *(const LAS bf16x8*)(L + ((ks * 3 + cf) * 2 + 0) * 1024 + lane * 16), bl = *(const LAS bf16x8*)(L + ((ks * 3 + cf) * 2 + 1) * 1024 + lane * 16);
                        acc[cf] = __builtin_amdgcn_mfma_f32_16x16x32_bf16(ah, bh, acc[cf], 0, 0, 0);
                        acc[cf] = __builtin_amdgcn_mfma_f32_16x16x32_bf16(ah, bl, acc[cf], 0, 0, 0);
                    }
                }
            }
            ssq += __shfl_xor(ssq, 16); ssq += __shfl_xor(ssq, 32);
            const float rs = 1.0f / sqrtf(ssq * (1.f / DM) + EPS);
            LAS float* zs = (LAS float*)(L + 98304) + wave * (16 * 48);
#pragma unroll
            for (int cf = 0; cf < 3; ++cf)
#pragma unroll
                for (int rg = 0; rg < 4; ++rg) zs[(4 * (lane >> 4) + rg) * 48 + 16 * cf + (lane & 15)] = acc[cf][rg];
            LDS_WAIT(); asm volatile("" ::: "memory");
            int e1 = 0, e2 = 0; float wgt1 = 0.f, wgt2 = 0.f; unsigned p1 = 0, p2 = 0;
            if (lane < 16) {
                const LAS float* zr = zs + lane * 48;
                float zg[4]; int g = 0; float zm;
#pragma unroll
                for (int i = 0; i < 4; ++i) zg[i] = zr[i] * rs + b_gr[i];
                zm = zg[0];
#pragma unroll
                for (int i = 1; i < 4; ++i) if (zg[i] > zm) { zm = zg[i]; g = i; }
                float den = 0.f;
#pragma unroll
                for (int i = 0; i < 4; ++i) den += __expf(zg[i] - zm);
                const float gp = 1.0f / den;
                float v1 = -3.0e38f, v2 = -3.0e38f; int i1 = 0, i2 = 0;
#pragma unroll
                for (int j = 0; j < 8; ++j) { const float z = zr[4 + 8 * g + j] * rs + b_er[8 * g + j];
                    if (z > v1) { v2 = v1; i2 = i1; v1 = z; i1 = j; } else if (z > v2) { v2 = z; i2 = j; } }
                const float w1 = 1.0f / (1.0f + __expf(v2 - v1));
                e1 = 8 * g + i1; e2 = 8 * g + i2; wgt1 = gp * w1; wgt2 = gp * (1.0f - w1);
                p1 = atomicAdd((unsigned*)(lds + MISC_OFF + 256) + e1, 1u); p2 = atomicAdd((unsigned*)(lds + MISC_OFF + 256) + e2, 1u);
                rstd2[row] = rs;
            }
            __syncthreads();
            if (tid < 32) lbase[tid] = atomicAdd(gcnt + tid, lcnt[tid]);
            __syncthreads();
            if (lane < 16) {
                const size_t i1 = (size_t)e1 * CAP + lbase[e1] + p1, i2 = (size_t)e2 * CAP + lbase[e2] + p2;
                ltok[i1] = row * 2; lw[i1] = wgt1; ltok[i2] = row * 2 + 1; lw[i2] = wgt2;
            }
            __syncthreads();
        }
    }
    if (args.mask & ~(1 << 7)) GRID_BAR();
    }

    LAS int* tstart = (LAS int*)(L + MISC_OFF + 1024); LAS int* ecnt = (LAS int*)(L + MISC_OFF + 1280); LAS int* tile_e = (LAS int*)(L + MISC_OFF + 1536);
    if (args.mask & (1 << 8)) {
        const int tid = wave * 64 + lane_id_fresh();
        if (tid == 0) { int acc = 0; for (int e = 0; e < 32; ++e) { const int c = (int)__hip_atomic_load(gcnt + e, __ATOMIC_RELAXED, __HIP_MEMORY_SCOPE_AGENT); ecnt[e] = c; tstart[e] = acc;
                const int nt_ = (c + 255) >> 8; for (int q = 0; q < nt_; ++q) tile_e[acc + q] = e; acc += nt_; } tstart[32] = acc; }
        __syncthreads();
    }
    if (args.mask & (1 << 8)) {
    {
        const int ntile = __builtin_amdgcn_readfirstlane(tstart[32]);
        pg8::MoeSched S; S.x1b = x1b; S.mid = mid; S.Wgu = Wt_gu; S.Wd = Wt_d; S.ltok = ltok; S.tcnt = ctl + CW_TCNT; S.tstart = tstart; S.cnt = ecnt; S.tile_e = tile_e; S.T = ntile; S.G = G; S.c = (G % 8 == 0) ? (bx % 8) * (G / 8) + bx / 8 : bx;
        pg8::EpiMoe E{pg8::EpiGU{ltok, lw, rstd2, mid}, pg8::EpiDown{ltok, ybuf}};
        pg8::gemm_phase_moe<pg8::EpiMoe, pg8::MoeSched>(L, wave, S, E);
    }
    if (args.mask & ~(1 << 8)) GRID_BAR();
    }

    if (args.mask & (1 << 10)) {
    {
        const int tid = wave * 64 + lane_id_fresh();
        for (size_t i = (size_t)bx * NTHR + tid; i < (size_t)NTOK * DM / 8; i += (size_t)G * NTHR) {
            f32x4 a0, a1, b0, b1; unpack8_fp8(*(const u32x2*)(ybuf + i * 8), 1.f / Y_SC, a0, a1); unpack8_fp8(*(const u32x2*)(ybuf + (size_t)NTOK * DM + i * 8), 1.f / Y_SC, b0, b1);
            f32x4 x0, x1_; load8(x1b + i * 8, x0, x1_); f32x4* o = (f32x4*)(out + i * 8); o[0] = x0 + a0 + b0; o[1] = x1_ + a1 + b1;
        }
    }
    }
}

extern "C" void kernel_launch(void* const* d_in, const int* in_sizes, int n_in, void* d_out, int out_size, void* d_ws, size_t ws_size, hipStream_t stream) {
    static int grid = 0;
    if (grid == 0) {
        if (n_in != 26 || out_size != NTOK * DM || ws_size < WS_END) { fprintf(stderr, "kernel_launch: unexpected shapes: n_in %d out %d ws %zu\n", n_in, out_size, ws_size); grid = -1; return; }
        int dev = 0, cus = 0;
        if (hipGetDevice(&dev) != hipSuccess || hipDeviceGetAttribute(&cus, hipDeviceAttributeMultiprocessorCount, dev) != hipSuccess) { grid = -1; return; }
        if (hipFuncSetAttribute((const void*)mk_fwd, hipFuncAttributeMaxDynamicSharedMemorySize, LDS_BYTES) != hipSuccess) { fprintf(stderr, "kernel_launch: hipFuncSetAttribute failed\n"); grid = -1; return; }
        int per_cu = 0;
        if (hipOccupancyMaxActiveBlocksPerMultiprocessor(&per_cu, (const void*)mk_fwd, NTHR, LDS_BYTES) != hipSuccess || per_cu < 1) fprintf(stderr, "kernel_launch: occupancy query reports %d\n", per_cu);
        (void)hipGetLastError();
        grid = cus;
    }
    if (grid < 0) return;
    (void)hipMemsetAsync((char*)d_ws + WS_CTL, 0, CTL_ZERO_BYTES, stream);
    Args a{};
    for (int i = 0; i < 26; ++i) a.in[i] = d_in[i];
    a.out = (float*)d_out; a.ws = (unsigned char*)d_ws;
#if USE_CG
    void* kargs[] = {&a};
    hipError_t le = hipLaunchCooperativeKernel((const void*)mk_fwd, dim3(grid), dim3(NTHR), kargs, LDS_BYTES, stream);
    if (le != hipSuccess) fprintf(stderr, "kernel_launch: cooperative launch failed: %s\n", hipGetErrorString(le));
#else
    a.mask = 0xfff; a.pad = 0;
    hipLaunchKernelGGL(mk_fwd, dim3(grid), dim3(NTHR), LDS_BYTES, stream, a);
#ifdef EXTRA_MASK
    { const int ms[] = EXTRA_MASK; for (int q = 0; q < (int)(sizeof(ms) / sizeof(int)); ++q) { a.mask = ms[q]; (void)hipMemsetAsync((char*)d_ws + WS_CTL, 0, 32768, stream); hipLaunchKernelGGL(mk_fwd, dim3(grid), dim3(NTHR), LDS_BYTES, stream, a); } }
#endif
#endif
}
```

```cpp
#include <hip/hip_runtime.h>
#include <hip/hip_cooperative_groups.h>
#include <cstdio>
#include <cstdint>

#define LAS __attribute__((address_space(3)))
typedef unsigned short bf16_t;
typedef short bf16x8 __attribute__((ext_vector_type(8)));
typedef short s16x4 __attribute__((ext_vector_type(4)));
typedef float f32x4 __attribute__((ext_vector_type(4)));
typedef float f32x16 __attribute__((ext_vector_type(16)));
typedef unsigned u32x4 __attribute__((ext_vector_type(4)));
typedef unsigned u32x2 __attribute__((ext_vector_type(2)));
typedef int v8i32 __attribute__((ext_vector_type(8)));

constexpr int NTOK = 32768, DM = 1024, SEQ = 2048, NBATCH = 16, NH = 8;
constexpr int INC = 3488, INP = 3584;
constexpr int QLR = 256, KVLR = 128, ROPE = 32, CONVW = 512, CONVK = 31;
constexpr int NEXP = 32, EFF = 256, CAP = NTOK;
constexpr float EPS = 1e-6f;
constexpr int NWAVES = 8, NTHR = 512;

constexpr size_t MiB = 1u << 20;
constexpr size_t WS_CTL = 0, CTL_ZERO_BYTES = 64 * 1024;
constexpr size_t WS_RSTD2 = 1 * MiB;
constexpr size_t WS_WRB = 1 * MiB + 256 * 1024;
constexpr size_t WS_WIN = 2 * MiB;
constexpr size_t WS_WQIMG = 9 * MiB;
constexpr size_t WS_WUKV = 9 * MiB + 512 * 1024;
constexpr size_t WS_RSTD1 = 1 * MiB + 512 * 1024;
constexpr size_t WS_WO = 10 * MiB;
constexpr size_t WS_WC = 11 * MiB;
constexpr size_t WS_WOUT = 12 * MiB;
constexpr size_t WS_WGU = 14 * MiB;
constexpr size_t WS_WD = 46 * MiB;
constexpr size_t WS_G = 64 * MiB;
constexpr size_t WS_XB8 = 128 * MiB;
constexpr size_t WS_A = 192 * MiB;
constexpr size_t WS_B = 256 * MiB;
constexpr size_t WS_C = 320 * MiB;
constexpr size_t WS_D = 384 * MiB;
constexpr size_t WS_E = 416 * MiB;
constexpr size_t WS_T = 464 * MiB;
constexpr size_t WS_END = 512 * MiB;
constexpr int CW_BAR = 1024;
constexpr int CW_CNT = 8192;
constexpr int CW_TCNT = 9216;

constexpr int RING_BYTES = 131072;
constexpr int LDS_BYTES = 147456;
constexpr int MISC_OFF = LDS_BYTES - 4096;
constexpr int LDS_BYTES_UNUSED_ = 0;

typedef float f32x2_t __attribute__((ext_vector_type(2))); typedef __bf16 bf16x2_t __attribute__((ext_vector_type(2)));
__device__ __forceinline__ unsigned cvt_pk_bf16(float lo, float hi) { f32x2_t v = {lo, hi}; bf16x2_t b = __builtin_convertvector(v, bf16x2_t); return __builtin_bit_cast(unsigned, b); }
__device__ __forceinline__ float bf_lo(unsigned w) { return __uint_as_float(w << 16); }
__device__ __forceinline__ float bf_hi(unsigned w) { return __uint_as_float(w & 0xffff0000u); }
__device__ __forceinline__ float bf2f(bf16_t b) { return __uint_as_float(((unsigned)b) << 16); }
__device__ __forceinline__ float sigmoidf_(float x) { return __builtin_amdgcn_rcpf(1.f + __builtin_amdgcn_exp2f(x * -1.4426950408889634f)); }
__device__ __forceinline__ float wave_sum(float v) {
#pragma unroll
    for (int o = 1; o < 64; o <<= 1) v += __shfl_xor(v, o);
    return v;
}
__device__ __forceinline__ void store8(bf16_t* p, f32x4 a, f32x4 b) {
    u32x4 w; w.x = cvt_pk_bf16(a[0], a[1]); w.y = cvt_pk_bf16(a[2], a[3]); w.z = cvt_pk_bf16(b[0], b[1]); w.w = cvt_pk_bf16(b[2], b[3]);
    *(u32x4*)p = w;
}
typedef _Float16 h16x2 __attribute__((ext_vector_type(2)));
__device__ __forceinline__ unsigned cvt_pk_f16(float a, float b) { const h16x2 h = {(_Float16)a, (_Float16)b}; return __builtin_bit_cast(unsigned, h); }
__device__ __forceinline__ void store8h(bf16_t* p, f32x4 a, f32x4 b) {
    u32x4 w; w.x = cvt_pk_f16(a[0], a[1]); w.y = cvt_pk_f16(a[2], a[3]); w.z = cvt_pk_f16(b[0], b[1]); w.w = cvt_pk_f16(b[2], b[3]);
    *(u32x4*)p = w;
}
__device__ __forceinline__ u32x4 pair16(u32x2 dA, u32x2 dB) {
    auto r0 = __builtin_amdgcn_permlane16_swap(dA.x, dB.x, false, false); auto r1 = __builtin_amdgcn_permlane16_swap(dA.y, dB.y, false, false);
    return (u32x4){r0[0], r1[0], r0[1], r1[1]};
}
__device__ __forceinline__ void unpair16(u32x4 L, u32x2& dA, u32x2& dB) {
    auto r0 = __builtin_amdgcn_permlane16_swap(L.x, L.z, false, false); auto r1 = __builtin_amdgcn_permlane16_swap(L.y, L.w, false, false);
    dA = (u32x2){r0[0], r1[0]}; dB = (u32x2){r0[1], r1[1]};
}
__device__ __forceinline__ void load8(const bf16_t* p, f32x4& a, f32x4& b) {
    const u32x4 w = *(const u32x4*)p;
    a = (f32x4){bf_lo(w.x), bf_hi(w.x), bf_lo(w.y), bf_hi(w.y)}; b = (f32x4){bf_lo(w.z), bf_hi(w.z), bf_lo(w.w), bf_hi(w.w)};
}
__device__ __forceinline__ int lane_id_fresh() { unsigned z = 0; asm volatile("" : "+s"(z)); return (int)__builtin_amdgcn_mbcnt_hi(~0u, __builtin_amdgcn_mbcnt_lo(~0u, z)); }
__device__ __forceinline__ u32x2 pack8_fp8(f32x4 a, f32x4 b, float sc) {
    int w0 = 0, w1 = 0;
    w0 = __builtin_amdgcn_cvt_pk_fp8_f32(a[0] * sc, a[1] * sc, w0, false); w0 = __builtin_amdgcn_cvt_pk_fp8_f32(a[2] * sc, a[3] * sc, w0, true);
    w1 = __builtin_amdgcn_cvt_pk_fp8_f32(b[0] * sc, b[1] * sc, w1, false); w1 = __builtin_amdgcn_cvt_pk_fp8_f32(b[2] * sc, b[3] * sc, w1, true);
    return (u32x2){(unsigned)w0, (unsigned)w1};
}
__device__ __forceinline__ void unpack8_fp8(u32x2 w, float isc, f32x4& a, f32x4& b) {
    const f32x2_t t0 = __builtin_amdgcn_cvt_pk_f32_fp8((int)w.x, false), t1 = __builtin_amdgcn_cvt_pk_f32_fp8((int)w.x, true);
    const f32x2_t t2 = __builtin_amdgcn_cvt_pk_f32_fp8((int)w.y, false), t3 = __builtin_amdgcn_cvt_pk_f32_fp8((int)w.y, true);
    a = (f32x4){t0[0] * isc, t0[1] * isc, t1[0] * isc, t1[1] * isc}; b = (f32x4){t2[0] * isc, t2[1] * isc, t3[0] * isc, t3[1] * isc};
}
__device__ __forceinline__ u32x2 pack8_u8(f32x4 a, f32x4 b) {
    unsigned w0 = 0, w1 = 0;
#pragma unroll
    for (int i = 0; i < 4; ++i) { w0 = __builtin_amdgcn_cvt_pk_u8_f32(__builtin_rintf(a[i] * 255.f), i, w0); w1 = __builtin_amdgcn_cvt_pk_u8_f32(__builtin_rintf(b[i] * 255.f), i, w1); }
    return (u32x2){w0, w1};
}
__device__ __forceinline__ void unpack8_u8(u32x2 w, f32x4& a, f32x4& b) {
    constexpr float k = 1.f / 255.f;
    a = (f32x4){(float)(w.x & 0xffu) * k, (float)((w.x >> 8) & 0xffu) * k, (float)((w.x >> 16) & 0xffu) * k, (float)(w.x >> 24) * k};
    b = (f32x4){(float)(w.y & 0xffu) * k, (float)((w.y >> 8) & 0xffu) * k, (float)((w.y >> 16) & 0xffu) * k, (float)(w.y >> 24) * k};
}
constexpr float MB_SC = 16.f, Y_SC = 16.f;
#define LDS_WAIT() asm volatile("s_waitcnt lgkmcnt(0)" ::: "memory")
#define VM_WAIT() asm volatile("s_waitcnt vmcnt(0)" ::: "memory")

#define XB_TMO      128
#define XB_XCNT(j)  (256  + 64 * (j))
#define XB_XSUB(j)  (1280 + 64 * (j))
#define XB_XGEN(j)  (2304 + 64 * (j))
#define XB_TOP      3328
#define XB_TOPGEN   3392
#define XCD_BAR_WORDS 3456
#define XB_SPIN_CAP (1u << 20)
__device__ __forceinline__ unsigned xb_ld(unsigned* p)              { return __hip_atomic_load(p, __ATOMIC_RELAXED, __HIP_MEMORY_SCOPE_AGENT); }
__device__ __forceinline__ unsigned xb_add(unsigned* p, unsigned v) { return __hip_atomic_fetch_add(p, v, __ATOMIC_RELAXED, __HIP_MEMORY_SCOPE_AGENT); }
__device__ __forceinline__ unsigned xb_xcc_id() { return (unsigned)__builtin_amdgcn_s_getreg((3 << 11) | 20) & 0xFu; }
#define XB_SPIN(cond, bar) do { unsigned _sp = 0; while (cond) { __builtin_amdgcn_s_sleep(1); \
    if ((++_sp & 255u) == 0u) { if (xb_ld(&(bar)[XB_TMO])) break; if (_sp > XB_SPIN_CAP) { atomicAdd(&(bar)[XB_TMO], 1u); break; } } } } while (0)
struct XcdBarrier { unsigned* bar; unsigned x; volatile LAS unsigned* st; };
__device__ __forceinline__ XcdBarrier xcd_barrier_post(unsigned* bar, volatile LAS unsigned* st) {
    XcdBarrier b; b.bar = bar; b.x = xb_xcc_id(); b.st = st;
    if (threadIdx.x == 0) (void)xb_add(&bar[XB_XCNT(b.x)], 1u);
    return b;
}
__device__ __forceinline__ void xcd_barrier_complete(unsigned* bar, unsigned x, unsigned& nloc, unsigned& nx) {
    const unsigned G = gridDim.x * gridDim.y * gridDim.z;
    unsigned sum, cnt, mine, sp = 0u;
    for (;;) {
        sum = 0u; cnt = 0u; mine = 0u;
#pragma unroll
        for (unsigned j = 0; j < 16; ++j) { const unsigned c = xb_ld(&bar[XB_XCNT(j)]); sum += c; cnt += (c > 0u) ? 1u : 0u; mine = (j == x) ? c : mine; }
        if (sum == G) break;
        __builtin_amdgcn_s_sleep(1);
        if ((++sp & 255u) == 0u) { if (xb_ld(&bar[XB_TMO])) break; if (sp > XB_SPIN_CAP) { atomicAdd(&bar[XB_TMO], 1u); break; } }
    }
    nloc = mine > 0u ? mine : 1u; nx = cnt > 0u ? cnt : 1u;
}
__device__ __forceinline__ void xcd_barrier(const XcdBarrier& b) {
    asm volatile("s_waitcnt vmcnt(0)" ::: "memory");
    __syncthreads();
    if (threadIdx.x == 0) {
        unsigned* bar = b.bar;
        __builtin_amdgcn_s_waitcnt(0);
        unsigned nloc = b.st[0], nx = b.st[1];
        if (nloc == 0u) { xcd_barrier_complete(bar, b.x, nloc, nx); b.st[0] = nloc; b.st[1] = nx; }
        const unsigned old = xb_add(&bar[XB_XSUB(b.x)], 1u);
        const unsigned gen = old / nloc;
        if (old + 1u == (gen + 1u) * nloc) {
            __builtin_amdgcn_fence(__ATOMIC_RELEASE, "agent");
            asm volatile("s_waitcnt vmcnt(0)" ::: "memory");
            const unsigned og = xb_add(&bar[XB_TOP], 1u);
            const unsigned tg = og / nx;
            if (og + 1u == (tg + 1u) * nx) xb_add(&bar[XB_TOPGEN], 1u);
            else XB_SPIN(xb_ld(&bar[XB_TOPGEN]) == tg, bar);
            __builtin_amdgcn_fence(__ATOMIC_ACQUIRE, "agent");
            xb_add(&bar[XB_XGEN(b.x)], 1u);
            asm volatile("s_waitcnt vmcnt(0)" ::: "memory");
        } else {
            XB_SPIN(xb_ld(&bar[XB_XGEN(b.x)]) == gen, bar);
            __builtin_amdgcn_fence(__ATOMIC_ACQUIRE, "agent");
            asm volatile("s_waitcnt vmcnt(0)" ::: "memory");
        }
    }
    __syncthreads();
}

namespace pg8 {
constexpr int BM = 256, BK = 64, HALF = 128, HTB = HALF * BK * 2, STAGE_BYTES = 8 * HTB, NXCD = 8, WGM = 8;
__device__ __forceinline__ int lds_byte(int r, int c) { const int st = (r >> 4) * 2 + (c >> 5), rr = r & 15, cc = c & 31, ob = rr * 64 + cc * 2; return st * 1024 + (ob ^ (((ob >> 9) & 1) << 5)); }
__device__ __forceinline__ void stage_rc(int b, int& R, int& C) { const int st = b / 1024, sb = b % 1024, swz = sb ^ (((sb >> 9) & 1) << 5); R = (st >> 1) * 16 + swz / 64; C = (st & 1) * 32 + (swz % 64) / 2; }
__device__ __forceinline__ int perm32(int rho) { const int n = rho >> 4, i = rho & 15; return 8 * (i >> 2) + 4 * n + (i & 3); }

struct Unit { int pm, pn, e, r0, nv, kind; };

struct DenseSched {
    static constexpr bool GATHER = false;
    const bf16_t* A; const bf16_t* Bt; int lda, ldb;
    int nM, nN, nwg, G, c, ntk = 0;
    __device__ __forceinline__ int nt(const Unit&) const { return ntk; }
    __device__ void init(const bf16_t* A_, int lda_, const bf16_t* Bt_, int ldb_, int M, int N, int G_, int c_) { A = A_; Bt = Bt_; lda = lda_; ldb = ldb_; nM = M / BM; nN = N / BM; nwg = nM * nN; G = G_; c = c_; }
    __device__ bool next(int i, Unit& u) const {
        const long L = (long)i * G + c; if (L >= nwg) return false;
        int wgid = (int)L; { const int q = nwg / NXCD, r = nwg % NXCD, xcd = wgid % NXCD, off = wgid / NXCD; wgid = (xcd < r ? xcd * (q + 1) : r * (q + 1) + (xcd - r) * q) + off; }
        const int nig = WGM * nN, gid = wgid / nig, fm = gid * WGM, gsz = (nM - fm) < WGM ? (nM - fm) : WGM;
        u.pm = fm + ((wgid % nig) % gsz); u.pn = (wgid % nig) / gsz; u.e = 0; u.r0 = 0; u.nv = 256; return true;
    }
    __device__ __forceinline__ const char* a_base(const Unit& u) const { return (const char*)(A + (size_t)u.pm * BM * lda); }
    __device__ __forceinline__ const char* b_base(const Unit& u) const { return (const char*)(Bt + (size_t)u.pn * BM * ldb); }
    __device__ __forceinline__ void a_rows(const Unit&, const int*, const int*, unsigned*, unsigned*) const {}
};
template <bool GATHER_, int NT>
struct GroupSched {
    static constexpr bool GATHER = GATHER_;
    const bf16_t* A; const bf16_t* Bt; int lda, ldb; size_t bstride;
    const int* ltok; const LAS int* tstart; const LAS int* cnt; const LAS int* tile_e; int nunits, G, c, ntk;
    __device__ __forceinline__ int nt(const Unit&) const { return ntk; }
    __device__ bool next(int i, Unit& u) const {
        const int L = i * G + c;
        if (L >= nunits) return false;
        const int tile = L / NT; u.pn = L % NT;
        const int e = __builtin_amdgcn_readfirstlane(tile_e[tile]);
        const int ts = __builtin_amdgcn_readfirstlane(tstart[e]), cn = __builtin_amdgcn_readfirstlane(cnt[e]);
        u.e = e; u.pm = tile; u.r0 = (tile - ts) * 256; const int rem = cn - u.r0; u.nv = rem < 256 ? rem : 256; return true;
    }
    __device__ __forceinline__ const char* a_base(const Unit& u) const { return GATHER ? (const char*)A : (const char*)(A + (size_t)u.pm * BM * lda); }
    __device__ __forceinline__ const char* b_base(const Unit& u) const { return (const char*)(Bt + (size_t)u.e * bstride + (size_t)u.pn * BM * ldb); }
    __device__ __forceinline__ void a_rows(const Unit& u, const int* R, const int* C, unsigned* v0, unsigned* v1) const {
        const int* lt = ltok + (size_t)u.e * CAP + u.r0;
#pragma unroll
        for (int i = 0; i < 2; ++i) {
            const int r0_ = R[i], r1_ = 128 + R[i];
            const int t0 = r0_ < u.nv ? (lt[r0_] >> 1) : 0;
            const int t1 = r1_ < u.nv ? (lt[r1_] >> 1) : 0;
            v0[i] = (unsigned)(t0 * lda + C[i]) * 2u; v1[i] = (unsigned)(t1 * lda + C[i]) * 2u;
        }
    }
};

struct MoeSched {
    const bf16_t* x1b; const bf16_t* mid; const bf16_t* Wgu; const bf16_t* Wd; const int* ltok; unsigned* tcnt;
    const LAS int* tstart; const LAS int* cnt; const LAS int* tile_e; int T, G, c;
    __device__ bool next(int i, Unit& u) const {
        const int full = (2 * T) / G, R3 = 2 * T - full * G, g = full + (c < R3 ? 1 : 0);
        int tile;
        if (i < g) { const int L = i * G + c; u.kind = 0; tile = L >> 1; u.pn = L & 1; }
        else { const int j = i - g, n_lo = G - R3; int d;
            if (R3 > 0 && c >= R3) d = j < 2 ? (c - R3) + n_lo * j : 2 * n_lo + c + G * (j - 2);
            else if (R3 > 0) d = 2 * n_lo + c + G * j;
            else d = c + G * j;
            if (d >= 4 * T) return false;
            u.kind = 1; tile = d >> 2; u.pn = d & 3; }
        const int e = __builtin_amdgcn_readfirstlane(tile_e[tile]);
        const int ts = __builtin_amdgcn_readfirstlane(tstart[e]), cn = __builtin_amdgcn_readfirstlane(cnt[e]);
        u.e = e; u.pm = tile; u.r0 = (tile - ts) * 256; const int rem = cn - u.r0; u.nv = rem < 256 ? rem : 256; return true;
    }
    __device__ __forceinline__ int nt(const Unit& u) const { return u.kind ? 4 : 16; }
    __device__ __forceinline__ int ldb(const Unit& u) const { return u.kind ? 256 : 1024; }
    __device__ __forceinline__ const char* a_base(const Unit& u) const { return u.kind ? (const char*)mid : (const char*)x1b; }
    __device__ __forceinline__ const char* b_base(const Unit& u) const {
        return u.kind ? (const char*)(Wd + (size_t)u.e * (1024 * 256) + (size_t)u.pn * (BM * 256)) : (const char*)(Wgu + (size_t)u.e * (512 * 1024) + (size_t)u.pn * (BM * 1024)); }
    __device__ __forceinline__ void a_rows(const Unit& u, const int* R, const int* C, unsigned* v0, unsigned* v1) const {
        if (u.kind) {
#pragma unroll
            for (int i = 0; i < 2; ++i) { v0[i] = (unsigned)((u.pm * BM + R[i]) * 256 + C[i]) * 2u; v1[i] = (unsigned)((u.pm * BM + 128 + R[i]) * 256 + C[i]) * 2u; }
        } else {
            const int* lt = ltok + (size_t)u.e * CAP + u.r0;
#pragma unroll
            for (int i = 0; i < 2; ++i) { const int r0_ = R[i], r1_ = 128 + R[i];
                const int t0 = r0_ < u.nv ? (lt[r0_] >> 1) : 0; const int t1 = r1_ < u.nv ? (lt[r1_] >> 1) : 0;
                v0[i] = (unsigned)(t0 * 1024 + C[i]) * 2u; v1[i] = (unsigned)(t1 * 1024 + C[i]) * 2u; }
        }
    }
    __device__ __forceinline__ void wait_ready(const Unit& u, bool& acquired) const {
        if (u.kind) {
            unsigned sp = 0;
            while ((unsigned)__builtin_amdgcn_readfirstlane((int)__hip_atomic_load(tcnt + u.pm, __ATOMIC_RELAXED, __HIP_MEMORY_SCOPE_AGENT)) < 2u) { __builtin_amdgcn_s_sleep(2); if (++sp > (1u << 22)) break; }
            if (!acquired) { __builtin_amdgcn_fence(__ATOMIC_ACQUIRE, "agent"); acquired = true; }
            asm volatile("" ::: "memory");
        }
    }
    __device__ __forceinline__ void publish(const Unit& u, int wid) const {
        if (!u.kind) {
            asm volatile("s_waitcnt vmcnt(0)" ::: "memory");
            __builtin_amdgcn_s_barrier();
            asm volatile("" ::: "memory");
            if (wid == 0 && lane_id_fresh() == 0) __hip_atomic_fetch_add(tcnt + u.pm, 1u, __ATOMIC_RELAXED, __HIP_MEMORY_SCOPE_AGENT);
        }
    }
};

struct QkvSched : DenseSched {
    __device__ __forceinline__ int nt(const Unit& u) const { return u.pn < 3 ? 4 : 2; }
    __device__ __forceinline__ const char* a_base(const Unit& u) const { return (const char*)(A + (size_t)u.pm * BM * lda + (u.pn < 3 ? 0 : 256)); }
};
struct YSched {
    static constexpr bool GATHER = false;
    const bf16_t* Ab; const bf16_t* Aa; const bf16_t* Bb; const bf16_t* Ba; int lda, ldb, G, c, nper;
    __device__ __forceinline__ int nt(const Unit&) const { return 8; }
    __device__ bool next(int i, Unit& u) const {
        if (i >= 2 * nper) return false;
        const int kind = i >= nper ? 1 : 0, tile = (kind ? i - nper : i) * G + c;
        if (tile >= 512) return false;
        int wgid = tile; { const int q = 512 / NXCD, xcd = wgid % NXCD, off = wgid / NXCD; wgid = xcd * q + off; }
        const int nig = WGM * 4, gid = wgid / nig, fm = gid * WGM;
        u.pm = fm + ((wgid % nig) % WGM); u.pn = (wgid % nig) / WGM; u.e = kind; u.r0 = 0; u.nv = 256; return true;
    }
    __device__ __forceinline__ const char* a_base(const Unit& u) const { return (const char*)((u.e ? Aa : Ab) + (size_t)u.pm * BM * lda); }
    __device__ __forceinline__ const char* b_base(const Unit& u) const { return (const char*)((u.e ? Ba : Bb) + (size_t)u.pn * BM * ldb); }
    __device__ __forceinline__ void a_rows(const Unit&, const int*, const int*, unsigned*, unsigned*) const {}
};

template <class Epi, class Sched, bool ALIGN_EPI, bool FP8 = false>
__device__ __forceinline__ void gemm_phase(LAS unsigned char* lds, const int wave_, const int K, const Sched& S, const Epi& E) {
    constexpr bool GATHER = Sched::GATHER;
    const int wid = wave_, lane = lane_id_fresh(), tid = wid * 64 + lane, wr = wid >> 2, wc = wid & 3, fr = lane & 15, fq = lane >> 4;
    const int lda = S.lda, ldb = S.ldb; (void)K;
    unsigned voffA[2], voffB[2]; int sR[2], sC[2];
#pragma unroll
    for (int i = 0; i < 2; ++i) { int R, C; stage_rc(tid * 16 + i * 8192, R, C); sR[i] = R; sC[i] = C; const int Rb = (R & ~31) + perm32(R & 31);
        voffA[i] = (unsigned)(R * lda + C) * 2u; voffB[i] = (unsigned)(Rb * ldb + C) * 2u; }
    const size_t kstep = (size_t)(BK * 2);
    const size_t hstepA = (size_t)HALF * lda * 2, hstepB = (size_t)HALF * ldb * 2;
    const unsigned ldsw = (unsigned)wid * 1024u;
    const int aoff = lds_byte(wr * 64 + fr, fq * 8), boff = lds_byte(wc * 32 + fr, fq * 8);
    unsigned cg0[2] = {0, 0}, cg1[2] = {0, 0}, ng0[2] = {0, 0}, ng1[2] = {0, 0};
#define PG8_SA(b, h) (((b) * 2 + (h)) * HTB)
#define PG8_SB(b, h) ((4 + (b) * 2 + (h)) * HTB)
#define PG8_GLDS(gp, bufoff, _i) __builtin_amdgcn_global_load_lds((const unsigned*)(gp), (LAS unsigned*)(lds + (bufoff) + ldsw + (_i) * 8192), 16, 0, 0)
#define PG8_STAGE_B(bufoff, gbase) do { _Pragma("unroll") for (int _i = 0; _i < 2; ++_i) PG8_GLDS((const char*)(gbase) + voffB[_i], bufoff, _i); } while (0)
#define PG8_STAGE_A(bufoff, kptr, h, nx) do { _Pragma("unroll") for (int _i = 0; _i < 2; ++_i) { const char* p_; \
        if constexpr (GATHER) p_ = (const char*)(kptr) + ((nx) ? ((h) ? ng1[_i] : ng0[_i]) : ((h) ? cg1[_i] : cg0[_i])); \
        else p_ = (const char*)(kptr) + (h) * hstepA + voffA[_i]; PG8_GLDS(p_, bufoff, _i); } } while (0)
#define PG8_LDA(dst, b, h) do { _Pragma("unroll") for (int m = 0; m < 4; ++m) { if constexpr (FP8) { const u32x4 l_ = *(const LAS u32x4*)(lds + PG8_SA(b, h) + aoff + m * 2048), h_ = *(const LAS u32x4*)(lds + PG8_SA(b, h) + aoff + m * 2048 + 1024); \
        dst##8[m] = (v8i32){(int)l_.x, (int)l_.y, (int)l_.z, (int)l_.w, (int)h_.x, (int)h_.y, (int)h_.z, (int)h_.w}; } \
        else { _Pragma("unroll") for (int k = 0; k < 2; ++k) dst[m][k] = *(const LAS bf16x8*)(lds + PG8_SA(b, h) + aoff + m * 2048 + k * 1024); } } } while (0)
#define PG8_LDB(dst, b, h) do { _Pragma("unroll") for (int n = 0; n < 2; ++n) { if constexpr (FP8) { const u32x4 l_ = *(const LAS u32x4*)(lds + PG8_SB(b, h) + boff + n * 2048), h_ = *(const LAS u32x4*)(lds + PG8_SB(b, h) + boff + n * 2048 + 1024); \
        dst##8[n] = (v8i32){(int)l_.x, (int)l_.y, (int)l_.z, (int)l_.w, (int)h_.x, (int)h_.y, (int)h_.z, (int)h_.w}; } \
        else { _Pragma("unroll") for (int k = 0; k < 2; ++k) dst[n][k] = *(const LAS bf16x8*)(lds + PG8_SB(b, h) + boff + n * 2048 + k * 1024); } } } while (0)
#define PG8_MMA(ai, bj, At, Bt) do { __builtin_amdgcn_s_setprio(1); _Pragma("unroll") for (int m = 0; m < 4; ++m) _Pragma("unroll") for (int n = 0; n < 2; ++n) { \
        if constexpr (FP8) acc[ai][bj][m][n] = __builtin_amdgcn_mfma_scale_f32_16x16x128_f8f6f4(Bt##8[n], At##8[m], acc[ai][bj][m][n], 0, 0, 0, 0x7f7f7f7f, 0, 0x7f7f7f7f); \
        else { _Pragma("unroll") for (int k = 0; k < 2; ++k) acc[ai][bj][m][n] = __builtin_amdgcn_mfma_f32_16x16x32_bf16(Bt[n][k], At[m][k], acc[ai][bj][m][n], 0, 0, 0); } } \
        if constexpr (FP8) { _Pragma("unroll") for (int m = 0; m < 4; ++m) asm volatile("" : "+v"(acc[ai][bj][m][0]), "+v"(acc[ai][bj][m][1])); } \
        __builtin_amdgcn_s_setprio(0); } while (0)
#define PG8_WAIT_V(n) asm volatile("s_waitcnt vmcnt(" #n ")" ::: "memory")
#define PG8_WAIT_L(n) asm volatile("s_waitcnt lgkmcnt(" #n ")" ::: "memory")
#define PG8_BAR __builtin_amdgcn_s_barrier()
#define PG8_SCHED __builtin_amdgcn_sched_barrier(0)
    Unit cur, nxt; int ui = 0;
    if (!S.next(0, cur)) return;
    f32x4 acc[2][2][4][2];
#pragma unroll
    for (int a = 0; a < 2; ++a)
#pragma unroll
        for (int b = 0; b < 2; ++b)
#pragma unroll
            for (int m = 0; m < 4; ++m)
#pragma unroll
                for (int n = 0; n < 2; ++n) acc[a][b][m][n] = (f32x4){0.f, 0.f, 0.f, 0.f};
    bf16x8 At[4][2], B0[2][2], B1[2][2]; v8i32 At8[4], B08[2], B18[2]; (void)At; (void)B0; (void)B1; (void)At8; (void)B08; (void)B18;
    const char* cA = S.a_base(cur); const char* cB = S.b_base(cur);
    if constexpr (GATHER) { S.a_rows(cur, sR, sC, cg0, cg1); }
    PG8_STAGE_B(PG8_SB(0, 0), cB); PG8_STAGE_B(PG8_SB(0, 1), cB + hstepB); PG8_STAGE_A(PG8_SA(0, 0), cA, 0, false); PG8_STAGE_A(PG8_SA(0, 1), cA, 1, false);
    if (wr == 1) PG8_BAR;
    PG8_WAIT_V(2); PG8_BAR;
    PG8_STAGE_B(PG8_SB(1, 0), cB + kstep); PG8_STAGE_A(PG8_SA(1, 0), cA + kstep, 0, false); PG8_STAGE_B(PG8_SB(1, 1), cB + hstepB + kstep);
    PG8_WAIT_V(6); PG8_BAR;
    for (;;) {
        const bool has_next = S.next(ui + 1, nxt);
        const char* nA = has_next ? S.a_base(nxt) : cA; const char* nB = has_next ? S.b_base(nxt) : cB;
        if constexpr (GATHER) { if (has_next) S.a_rows(nxt, sR, sC, ng0, ng1); else { ng0[0] = cg0[0]; ng0[1] = cg0[1]; ng1[0] = cg1[0]; ng1[1] = cg1[1]; } }
        const int nt = S.nt(cur);
        for (int t = 0; t < nt; t += 2) {
            const bool last = (t == nt - 2);
            const char* a1 = cA + (size_t)(t + 1) * kstep;
            const char* a2 = last ? nA : cA + (size_t)(t + 2) * kstep; const char* b2 = last ? nB : cB + (size_t)(t + 2) * kstep;
            const char* a3 = a2 + kstep; const char* b3 = b2 + kstep;
            PG8_LDB(B0, 0, 0); PG8_LDB(B1, 0, 1); PG8_SCHED; PG8_LDA(At, 0, 0); PG8_STAGE_A(PG8_SA(1, 1), a1, 1, false);
            PG8_WAIT_V(8); PG8_WAIT_L(0); PG8_BAR; PG8_MMA(0, 0, At, B0); PG8_MMA(0, 1, At, B1); PG8_BAR; PG8_SCHED;
            PG8_LDA(At, 0, 1); PG8_STAGE_B(PG8_SB(0, 0), b2); PG8_STAGE_B(PG8_SB(0, 1), b2 + hstepB); PG8_STAGE_A(PG8_SA(0, 0), a2, 0, last);
            PG8_WAIT_V(8); PG8_WAIT_L(0); PG8_BAR; PG8_MMA(1, 0, At, B0); PG8_MMA(1, 1, At, B1); PG8_BAR; PG8_SCHED;
            PG8_LDB(B0, 1, 0); PG8_LDB(B1, 1, 1); PG8_SCHED; PG8_LDA(At, 1, 0); PG8_STAGE_A(PG8_SA(0, 1), a2, 1, last);
            PG8_WAIT_V(8); PG8_WAIT_L(0); PG8_BAR; PG8_MMA(0, 0, At, B0); PG8_MMA(0, 1, At, B1); PG8_BAR; PG8_SCHED;
            PG8_LDA(At, 1, 1); PG8_STAGE_B(PG8_SB(1, 0), b3); PG8_STAGE_B(PG8_SB(1, 1), b3 + hstepB); PG8_STAGE_A(PG8_SA(1, 0), a3, 0, last);
            PG8_WAIT_V(8); PG8_WAIT_L(0); PG8_BAR; PG8_MMA(1, 0, At, B0); PG8_MMA(1, 1, At, B1); PG8_BAR; PG8_SCHED;
        }
        if constexpr (ALIGN_EPI) { if (wr == 0) PG8_BAR; }
        { const int l2_ = lane_id_fresh(); E(acc, cur, wr, wc, l2_ & 15, l2_ >> 4); }
        if (!has_next) break;
#pragma unroll
        for (int a = 0; a < 2; ++a)
#pragma unroll
            for (int b = 0; b < 2; ++b)
#pragma unroll
                for (int m = 0; m < 4; ++m)
#pragma unroll
                    for (int n = 0; n < 2; ++n) acc[a][b][m][n] = (f32x4){0.f, 0.f, 0.f, 0.f};
        cur = nxt; cA = nA; cB = nB; ++ui;
        if constexpr (GATHER) { cg0[0] = ng0[0]; cg0[1] = ng0[1]; cg1[0] = ng1[0]; cg1[1] = ng1[1]; }
        if constexpr (ALIGN_EPI) { if (wr == 1) PG8_BAR; }
    }
    PG8_WAIT_V(0);
    if constexpr (!ALIGN_EPI) { if (wr == 0) PG8_BAR; }
    PG8_BAR;
#undef PG8_SA
#undef PG8_SB
#undef PG8_GLDS
#undef PG8_STAGE_A
#undef PG8_STAGE_B
#undef PG8_LDA
#undef PG8_LDB
#undef PG8_MMA
#undef PG8_WAIT_V
#undef PG8_WAIT_L
#undef PG8_BAR
#undef PG8_SCHED
}

template <class Epi, class Sched>
__device__ __forceinline__ void gemm_phase_moe(LAS unsigned char* lds, const int wave_, const Sched& S, const Epi& E) {
    constexpr bool GATHER = true, ALIGN_EPI = true;
    const int wid = wave_, lane = lane_id_fresh(), tid = wid * 64 + lane, wr = wid >> 2, wc = wid & 3, fr = lane & 15, fq = lane >> 4;
    int sR[2], sC[2];
#pragma unroll
    for (int i = 0; i < 2; ++i) { int R, C; stage_rc(tid * 16 + i * 8192, R, C); sR[i] = R; sC[i] = C; }
    const size_t kstep = (size_t)(BK * 2);
    unsigned cvB[2] = {0, 0}, nvB[2] = {0, 0}; unsigned chB = 0, nhB = 0;
#define PG8_SET_B(u, vB, hB) do { const int ldb_ = S.ldb(u); hB = (unsigned)(HALF * ldb_ * 2); _Pragma("unroll") for (int _i = 0; _i < 2; ++_i) vB[_i] = (unsigned)(((sR[_i] & ~31) + perm32(sR[_i] & 31)) * ldb_ + sC[_i]) * 2u; } while (0)
    const unsigned ldsw = (unsigned)wid * 1024u;
    const int aoff = lds_byte(wr * 64 + fr, fq * 8), boff = lds_byte(wc * 32 + fr, fq * 8);
    unsigned cg0[2] = {0, 0}, cg1[2] = {0, 0}, ng0[2] = {0, 0}, ng1[2] = {0, 0};
#define PG8_SA(b, h) (((b) * 2 + (h)) * HTB)
#define PG8_SB(b, h) ((4 + (b) * 2 + (h)) * HTB)
#define PG8_GLDS(gp, bufoff, _i) __builtin_amdgcn_global_load_lds((const unsigned*)(gp), (LAS unsigned*)(lds + (bufoff) + ldsw + (_i) * 8192), 16, 0, 0)
#define PG8_STAGE_B(bufoff, kptr, h, nx) do { _Pragma("unroll") for (int _i = 0; _i < 2; ++_i) PG8_GLDS((const char*)(kptr) + ((h) ? ((nx) ? nhB : chB) : 0u) + ((nx) ? nvB[_i] : cvB[_i]), bufoff, _i); } while (0)
#define PG8_STAGE_A(bufoff, kptr, h, nx) do { _Pragma("unroll") for (int _i = 0; _i < 2; ++_i) { const char* p_; \
        p_ = (const char*)(kptr) + ((nx) ? ((h) ? ng1[_i] : ng0[_i]) : ((h) ? cg1[_i] : cg0[_i])); PG8_GLDS(p_, bufoff, _i); } } while (0)
#define PG8_LDA(dst, b, h) do { _Pragma("unroll") for (int m = 0; m < 4; ++m) _Pragma("unroll") for (int k = 0; k < 2; ++k) dst[m][k] = *(const LAS bf16x8*)(lds + PG8_SA(b, h) + aoff + m * 2048 + k * 1024); } while (0)
#define PG8_LDB(dst, b, h) do { _Pragma("unroll") for (int n = 0; n < 2; ++n) _Pragma("unroll") for (int k = 0; k < 2; ++k) dst[n][k] = *(const LAS bf16x8*)(lds + PG8_SB(b, h) + boff + n * 2048 + k * 1024); } while (0)
#define PG8_MMA(ai, bj, At, Bt) do { __builtin_amdgcn_s_setprio(1); _Pragma("unroll") for (int m = 0; m < 4; ++m) _Pragma("unroll") for (int n = 0; n < 2; ++n) _Pragma("unroll") for (int k = 0; k < 2; ++k) \
        acc[ai][bj][m][n] = __builtin_amdgcn_mfma_f32_16x16x32_bf16(Bt[n][k], At[m][k], acc[ai][bj][m][n], 0, 0, 0); __builtin_amdgcn_s_setprio(0); } while (0)
#define PG8_WAIT_V(n) asm volatile("s_waitcnt vmcnt(" #n ")" ::: "memory")
#define PG8_WAIT_L(n) asm volatile("s_waitcnt lgkmcnt(" #n ")" ::: "memory")
#define PG8_BAR __builtin_amdgcn_s_barrier()
#define PG8_SCHED __builtin_amdgcn_sched_barrier(0)
    Unit cur, nxt; int ui = 0;
    if (!S.next(0, cur)) return;
    f32x4 acc[2][2][4][2];
#pragma unroll
    for (int a = 0; a < 2; ++a)
#pragma unroll
        for (int b = 0; b < 2; ++b)
#pragma unroll
            for (int m = 0; m < 4; ++m)
#pragma unroll
                for (int n = 0; n < 2; ++n) acc[a][b][m][n] = (f32x4){0.f, 0.f, 0.f, 0.f};
    bf16x8 At[4][2], B0[2][2], B1[2][2];
    const char* cA = S.a_base(cur); const char* cB = S.b_base(cur);
    bool acquired = false;
    S.wait_ready(cur, acquired);
    S.a_rows(cur, sR, sC, cg0, cg1); PG8_SET_B(cur, cvB, chB);
    PG8_STAGE_B(PG8_SB(0, 0), cB, 0, false); PG8_STAGE_B(PG8_SB(0, 1), cB, 1, false); PG8_STAGE_A(PG8_SA(0, 0), cA, 0, false); PG8_STAGE_A(PG8_SA(0, 1), cA, 1, false);
    if (wr == 1) PG8_BAR;
    PG8_WAIT_V(2); PG8_BAR;
    PG8_STAGE_B(PG8_SB(1, 0), cB + kstep, 0, false); PG8_STAGE_A(PG8_SA(1, 0), cA + kstep, 0, false); PG8_STAGE_B(PG8_SB(1, 1), cB + kstep, 1, false);
    PG8_WAIT_V(6); PG8_BAR;
    for (;;) {
        const bool has_next = S.next(ui + 1, nxt);
        const char* nA = has_next ? S.a_base(nxt) : cA; const char* nB = has_next ? S.b_base(nxt) : cB;
        if (has_next) { S.wait_ready(nxt, acquired); S.a_rows(nxt, sR, sC, ng0, ng1); PG8_SET_B(nxt, nvB, nhB); }
        else { ng0[0] = cg0[0]; ng0[1] = cg0[1]; ng1[0] = cg1[0]; ng1[1] = cg1[1]; nvB[0] = cvB[0]; nvB[1] = cvB[1]; nhB = chB; }
        const int nt = S.nt(cur);
        for (int t = 0; t < nt; t += 2) {
            const bool last = (t == nt - 2);
            const char* a1 = cA + (size_t)(t + 1) * kstep;
            const char* a2 = last ? nA : cA + (size_t)(t + 2) * kstep; const char* b2 = last ? nB : cB + (size_t)(t + 2) * kstep;
            const char* a3 = a2 + kstep; const char* b3 = b2 + kstep;
            PG8_LDB(B0, 0, 0); PG8_LDB(B1, 0, 1); PG8_SCHED; PG8_LDA(At, 0, 0); PG8_STAGE_A(PG8_SA(1, 1), a1, 1, false);
            PG8_WAIT_V(8); PG8_WAIT_L(0); PG8_BAR; PG8_MMA(0, 0, At, B0); PG8_MMA(0, 1, At, B1); PG8_BAR; PG8_SCHED;
            PG8_LDA(At, 0, 1); PG8_STAGE_B(PG8_SB(0, 0), b2, 0, last); PG8_STAGE_B(PG8_SB(0, 1), b2, 1, last); PG8_STAGE_A(PG8_SA(0, 0), a2, 0, last);
            PG8_WAIT_V(8); PG8_WAIT_L(0); PG8_BAR; PG8_MMA(1, 0, At, B0); PG8_MMA(1, 1, At, B1); PG8_BAR; PG8_SCHED;
            PG8_LDB(B0, 1, 0); PG8_LDB(B1, 1, 1); PG8_SCHED; PG8_LDA(At, 1, 0); PG8_STAGE_A(PG8_SA(0, 1), a2, 1, last);
            PG8_WAIT_V(8); PG8_WAIT_L(0); PG8_BAR; PG8_MMA(0, 0, At, B0); PG8_MMA(0, 1, At, B1); PG8_BAR; PG8_SCHED;
            PG8_LDA(At, 1, 1); PG8_STAGE_B(PG8_SB(1, 0), b3, 0, last); PG8_STAGE_B(PG8_SB(1, 1), b3, 1, last); PG8_STAGE_A(PG8_SA(1, 0), a3, 0, last);
            PG8_WAIT_V(8); PG8_WAIT_L(0); PG8_BAR; PG8_MMA(1, 0, At, B0); PG8_MMA(1, 1, At, B1); PG8_BAR; PG8_SCHED;
        }
        if constexpr (ALIGN_EPI) { if (wr == 0) PG8_BAR; }
        { const int l2_ = lane_id_fresh(); E(acc, cur, wr, wc, l2_ & 15, l2_ >> 4); }
        S.publish(cur, wid);
        if (!has_next) break;
#pragma unroll
        for (int a = 0; a < 2; ++a)
#pragma unroll
            for (int b = 0; b < 2; ++b)
#pragma unroll
                for (int m = 0; m < 4; ++m)
#pragma unroll
                    for (int n = 0; n < 2; ++n) acc[a][b][m][n] = (f32x4){0.f, 0.f, 0.f, 0.f};
        cur = nxt; cA = nA; cB = nB; ++ui;
        cg0[0] = ng0[0]; cg0[1] = ng0[1]; cg1[0] = ng1[0]; cg1[1] = ng1[1]; cvB[0] = nvB[0]; cvB[1] = nvB[1]; chB = nhB;
        if constexpr (ALIGN_EPI) { if (wr == 1) PG8_BAR; }
    }
    PG8_WAIT_V(0);
    if constexpr (!ALIGN_EPI) { if (wr == 0) PG8_BAR; }
    PG8_BAR;
#undef PG8_SET_B
#undef PG8_SA
#undef PG8_SB
#undef PG8_GLDS
#undef PG8_STAGE_A
#undef PG8_STAGE_B
#undef PG8_LDA
#undef PG8_LDB
#undef PG8_MMA
#undef PG8_WAIT_V
#undef PG8_WAIT_L
#undef PG8_BAR
#undef PG8_SCHED
}


typedef f32x4 Acc[2][2][4][2];

struct EpiG1 {
    bf16_t* qkvd; bf16_t* u; unsigned char* gates; const float* bg; const float* rstd1;
    float* ssq_kv; float* ssq_rope; bf16_t* krr; const float* cstab; const float* gk;
    __device__ __forceinline__ void operator()(const Acc& acc, const Unit& un, int wr, int wc, int fr, int fq) const {
        const int row0 = un.pm * BM + wr * 64 + fr, c8 = wc * 32 + 8 * fq, pn = un.pn;
        if (pn < 2) {
#pragma unroll
            for (int ai = 0; ai < 2; ++ai)
#pragma unroll
                for (int m = 0; m < 4; ++m) { const int row = row0 + ai * HALF + m * 16; bf16_t* rowp = qkvd + (size_t)row * 512 + pn * 256 + c8;
                    f32x4 v[2][2];
#pragma unroll
                    for (int bj = 0; bj < 2; ++bj) { v[bj][0] = acc[ai][bj][m][0]; v[bj][1] = acc[ai][bj][m][1]; store8(rowp + bj * HALF, v[bj][0], v[bj][1]); }
                    if (pn == 1) {
                        float ss = (v[0][0][0] * v[0][0][0] + v[0][0][1] * v[0][0][1]) + (v[0][0][2] * v[0][0][2] + v[0][0][3] * v[0][0][3]) + (v[0][1][0] * v[0][1][0] + v[0][1][1] * v[0][1][1]) + (v[0][1][2] * v[0][1][2] + v[0][1][3] * v[0][1][3]);
                        ss += __shfl_xor(ss, 16); ss += __shfl_xor(ss, 32);
                        if (fq == 0) ssq_kv[(size_t)row * 4 + wc] = ss;
                        if (wc == 0) {
                            float kv_[8], sr = 0.f;
#pragma unroll
                            for (int n = 0; n < 2; ++n)
#pragma unroll
                                for (int i = 0; i < 4; ++i) { const float t = v[1][n][i]; sr += t * t; kv_[4 * n + i] = t * gk[64 + 8 * fq + 4 * n + i]; }
                            sr += __shfl_xor(sr, 16); sr += __shfl_xor(sr, 32);
                            if (fq == 0) ssq_rope[row] = sr;
                            const float* cs = cstab + (size_t)row * 32 + 8 * (fq & 1);
                            const f32x4 c0 = *(const f32x4*)cs, c1 = *(const f32x4*)(cs + 4), s0 = *(const f32x4*)(cs + 16), s1 = *(const f32x4*)(cs + 20);
                            f32x4 o0, o1;
#pragma unroll
                            for (int i = 0; i < 4; ++i) { const float p0 = __shfl_xor(kv_[i], 32), p1 = __shfl_xor(kv_[4 + i], 32);
                                o0[i] = fq < 2 ? kv_[i] * c0[i] - p0 * s0[i] : kv_[i] * c0[i] + p0 * s0[i];
                                o1[i] = fq < 2 ? kv_[4 + i] * c1[i] - p1 * s1[i] : kv_[4 + i] * c1[i] + p1 * s1[i]; }
                            store8(krr + (size_t)row * 32 + 8 * fq, o0, o1);
                        } } }
        } else if (pn < 6) {
            const int t = pn - 2;
#pragma unroll
            for (int ai = 0; ai < 2; ++ai)
#pragma unroll
                for (int m = 0; m < 4; ++m) { f32x4 o[2];
#pragma unroll
                    for (int n = 0; n < 2; ++n) { const f32x4 v = acc[ai][0][m][n], g = acc[ai][1][m][n];
#pragma unroll
                        for (int i = 0; i < 4; ++i) o[n][i] = v[i] * sigmoidf_(g[i]); }
                    store8h(u + (size_t)(row0 + ai * HALF + m * 16) * 512 + t * 128 + c8, o[0], o[1]); }
        } else {
            const int gcol = (pn - 6) * 256;
#pragma unroll
            for (int bj = 0; bj < 2; ++bj) {
                const f32x4 b0 = *(const f32x4*)(bg + gcol + bj * HALF + c8), b1 = *(const f32x4*)(bg + gcol + bj * HALF + c8 + 4);
#pragma unroll
                for (int ai = 0; ai < 2; ++ai)
#pragma unroll
                    for (int m = 0; m < 4; ++m) { f32x4 o0, o1;
#pragma unroll
                        for (int i = 0; i < 4; ++i) { o0[i] = sigmoidf_(acc[ai][bj][m][0][i] + b0[i]); o1[i] = sigmoidf_(acc[ai][bj][m][1][i] + b1[i]); }
                        *(u32x2*)(gates + (size_t)(row0 + ai * HALF + m * 16) * 2048 + gcol + bj * HALF + c8) = pack8_u8(o0, o1); }
            }
        }
    }
};
struct EpiGates {
    unsigned char* gates; const float* bg;
    __device__ __forceinline__ void operator()(const Acc& acc, const Unit& un, int wr, int wc, int fr, int fq) const {
        const int row0 = un.pm * BM + wr * 64 + fr, c8 = wc * 32 + 8 * fq, gcol = un.pn * 256, c16 = wc * 32 + 8 * (fq & ~1), odd = fq & 1;
        constexpr float L2E = 1.4426950408889634f, K255 = 1.f / 255.f;
#pragma unroll
        for (int bj = 0; bj < 2; ++bj) {
            const f32x4 b0 = *(const f32x4*)(bg + gcol + bj * HALF + c8) * -L2E, b1 = *(const f32x4*)(bg + gcol + bj * HALF + c8 + 4) * -L2E;
#pragma unroll
            for (int ai = 0; ai < 2; ++ai)
#pragma unroll
                for (int mp = 0; mp < 2; ++mp) { u32x2 d[2];
#pragma unroll
                    for (int q = 0; q < 2; ++q) { const int m = 2 * mp + q; unsigned w0 = 0, w1 = 0;
#pragma unroll
                        for (int i = 0; i < 4; ++i) {
                            const float e0 = __builtin_amdgcn_exp2f(fmaf(acc[ai][bj][m][0][i], -0.0625f * L2E, b0[i])), e1 = __builtin_amdgcn_exp2f(fmaf(acc[ai][bj][m][1][i], -0.0625f * L2E, b1[i]));
                            w0 = __builtin_amdgcn_cvt_pk_u8_f32(__builtin_rintf(__builtin_amdgcn_rcpf(fmaf(e0, K255, K255))), i, w0);
                            w1 = __builtin_amdgcn_cvt_pk_u8_f32(__builtin_rintf(__builtin_amdgcn_rcpf(fmaf(e1, K255, K255))), i, w1); }
                        d[q] = (u32x2){w0, w1}; }
                    *(u32x4*)(gates + (size_t)(row0 + ai * HALF + (2 * mp + odd) * 16) * 2048 + gcol + bj * HALF + c16) = pair16(d[0], d[1]); }
        }
    }
};
struct EpiPlain {
    bf16_t* O; int ldc;
    __device__ __forceinline__ void operator()(const Acc& acc, const Unit& un, int wr, int wc, int fr, int fq) const {
        asm volatile("" : "+v"(fr), "+v"(fq));
        const int row0 = un.pm * BM + wr * 64 + fr, c8 = un.pn * BM + wc * 32 + 8 * fq;
#pragma unroll
        for (int ai = 0; ai < 2; ++ai)
#pragma unroll
            for (int m = 0; m < 4; ++m) { bf16_t* rowp = O + (size_t)(row0 + ai * HALF + m * 16) * ldc + c8;
#pragma unroll
                for (int bj = 0; bj < 2; ++bj) store8(rowp + bj * HALF, acc[ai][bj][m][0], acc[ai][bj][m][1]); }
    }
};
__device__ __forceinline__ int kimg_off(int r, int c) { return r * 192 + ((c ^ ((r >> 2) & 3)) << 4); }
__device__ __forceinline__ int vimg_off(int k, int c) { const int kk = (k & ~0xC) | ((k & 4) << 1) | ((k & 8) >> 1); return ((kk >> 3) * 2 + (c >> 5)) * 512 + ((kk & 7) * 32 + (c & 31)) * 2; }
struct EpiKV {
    const float* ssq_kv; const float* ssq_rope; const bf16_t* krr; const float* gk; bf16_t* K; bf16_t* V;
    __device__ __forceinline__ void operator()(const Acc& acc, const Unit& un, int wr, int wc, int fr, int fq) const {
        const int row0 = un.pm * BM + wr * 64 + fr, head = 2 * un.pn + (wc & 1);
        if (wc >= 2) {
            float sk[8];
#pragma unroll
            for (int q = 0; q < 8; ++q) { const f32x4 p4 = *(const f32x4*)(ssq_kv + (size_t)(row0 + (q >> 2) * HALF + (q & 3) * 16) * 4); sk[q] = (p4[0] + p4[1]) + (p4[2] + p4[3]); }
#pragma unroll
            for (int q = 0; q < 8; ++q) { const int ai = q >> 2, m = q & 3, row = row0 + ai * HALF + m * 16; const float rkv = __builtin_amdgcn_rsqf(sk[q] * (1.f / KVLR) + EPS);
                const int t = row & (SEQ - 1);
                char* dst = (char*)(V + (size_t)((row >> 11) * NH + head) * SEQ * 64) + (size_t)(t >> 6) * 8192;
#pragma unroll
                for (int bj = 0; bj < 2; ++bj) store8((bf16_t*)(dst + vimg_off(t & 63, 32 * bj + 8 * fq)), acc[ai][bj][m][0] * rkv, acc[ai][bj][m][1] * rkv); }
        } else {
            f32x4 g[2][2];
#pragma unroll
            for (int bj = 0; bj < 2; ++bj)
#pragma unroll
                for (int n = 0; n < 2; ++n) g[bj][n] = *(const f32x4*)(gk + 32 * bj + 8 * fq + 4 * n);
#pragma unroll
            for (int ai = 0; ai < 2; ++ai) {
                float sk[4], sr[4]; u32x4 KR[4];
#pragma unroll
                for (int m = 0; m < 4; ++m) { const int row = row0 + ai * HALF + m * 16; { const f32x4 p4 = *(const f32x4*)(ssq_kv + (size_t)row * 4); sk[m] = (p4[0] + p4[1]) + (p4[2] + p4[3]); } sr[m] = ssq_rope[row]; KR[m] = *(const u32x4*)(krr + (size_t)row * 32 + 8 * fq); }
#pragma unroll
                for (int m = 0; m < 4; ++m) { const int row = row0 + ai * HALF + m * 16; const float rkv = __builtin_amdgcn_rsqf(sk[m] * (1.f / KVLR) + EPS);
                    f32x4 v[2][2]; float ss = 0.f;
#pragma unroll
                    for (int bj = 0; bj < 2; ++bj)
#pragma unroll
                        for (int n = 0; n < 2; ++n) { v[bj][n] = acc[ai][bj][m][n] * rkv; ss += (v[bj][n][0] * v[bj][n][0] + v[bj][n][1] * v[bj][n][1]) + (v[bj][n][2] * v[bj][n][2] + v[bj][n][3] * v[bj][n][3]); }
                    ss += __shfl_xor(ss, 16); ss += __shfl_xor(ss, 32);
                    const float rh = __builtin_amdgcn_rsqf((ss + sr[m]) * (1.f / 96.f) + EPS);
                    const int t = row & (SEQ - 1), r = t & 63;
                    char* dst = (char*)(K + (size_t)((row >> 11) * NH + head) * SEQ * 96) + (size_t)(t >> 6) * 12288;
#pragma unroll
                    for (int bj = 0; bj < 2; ++bj) store8((bf16_t*)(dst + kimg_off(r, 4 * bj + fq)), v[bj][0] * g[bj][0] * rh, v[bj][1] * g[bj][1] * rh);
                    const u32x4 kw = KR[m]; const f32x4 k0 = (f32x4){bf_lo(kw.x), bf_hi(kw.x), bf_lo(kw.y), bf_hi(kw.y)}, k1 = (f32x4){bf_lo(kw.z), bf_hi(kw.z), bf_lo(kw.w), bf_hi(kw.w)};
                    store8((bf16_t*)(dst + kimg_off(r, 8 + fq)), k0 * rh, k1 * rh); }
            }
        }
    }
};
struct EpiMulGate {
    const unsigned char* gates; int goff; unsigned char* O;
    __device__ __forceinline__ void operator()(const Acc& acc, const Unit& un, int wr, int wc, int fr, int fq) const {
        const int row0 = un.pm * BM + wr * 64 + fr, c16 = un.pn * BM + wc * 32 + 8 * (fq & ~1), odd = fq & 1;
#pragma unroll
        for (int ai = 0; ai < 2; ++ai) {
            u32x4 G[2][2];
#pragma unroll
            for (int mp = 0; mp < 2; ++mp) { const size_t r = (size_t)(row0 + ai * HALF + (2 * mp + odd) * 16);
#pragma unroll
                for (int bj = 0; bj < 2; ++bj) G[mp][bj] = *(const u32x4*)(gates + r * 2048 + goff + c16 + bj * HALF); }
#pragma unroll
            for (int mp = 0; mp < 2; ++mp) { const size_t r = (size_t)(row0 + ai * HALF + (2 * mp + odd) * 16);
#pragma unroll
                for (int bj = 0; bj < 2; ++bj) { u32x2 gA, gB; unpair16(G[mp][bj], gA, gB); f32x4 g0, g1, h0, h1; unpack8_u8(gA, g0, g1); unpack8_u8(gB, h0, h1);
                    const u32x2 oA = pack8_fp8(acc[ai][bj][2 * mp][0] * g0, acc[ai][bj][2 * mp][1] * g1, MB_SC), oB = pack8_fp8(acc[ai][bj][2 * mp + 1][0] * h0, acc[ai][bj][2 * mp + 1][1] * h1, MB_SC);
                    *(u32x4*)(O + r * 1024 + c16 + bj * HALF) = pair16(oA, oB); } }
        }
    }
};
struct EpiMerge {
    const unsigned char* gates; const unsigned char* mb; bf16_t* O;
    __device__ __forceinline__ void operator()(const Acc& acc, const Unit& un, int wr, int wc, int fr, int fq) const {
        const int row0 = un.pm * BM + wr * 64 + fr, c8 = un.pn * BM + wc * 32 + 8 * fq, c16 = un.pn * BM + wc * 32 + 8 * (fq & ~1), odd = fq & 1;
#pragma unroll
        for (int ai = 0; ai < 2; ++ai) {
            u32x4 G[2][2], Y[2][2];
#pragma unroll
            for (int mp = 0; mp < 2; ++mp) { const size_t r = (size_t)(row0 + ai * HALF + (2 * mp + odd) * 16);
#pragma unroll
                for (int bj = 0; bj < 2; ++bj) { G[mp][bj] = *(const u32x4*)(gates + r * 2048 + c16 + bj * HALF); Y[mp][bj] = *(const u32x4*)(mb + r * 1024 + c16 + bj * HALF); } }
#pragma unroll
            for (int mp = 0; mp < 2; ++mp)
#pragma unroll
                for (int bj = 0; bj < 2; ++bj) { u32x2 gq[2], yq[2]; unpair16(G[mp][bj], gq[0], gq[1]); unpair16(Y[mp][bj], yq[0], yq[1]);
#pragma unroll
                    for (int q = 0; q < 2; ++q) { const int m = 2 * mp + q; const size_t r = (size_t)(row0 + ai * HALF + m * 16);
                        f32x4 g0, g1, y0, y1; unpack8_u8(gq[q], g0, g1); unpack8_fp8(yq[q], 1.f / MB_SC, y0, y1);
                        store8(O + r * 1024 + c8 + bj * HALF, acc[ai][bj][m][0] * g0 + y0, acc[ai][bj][m][1] * g1 + y1); } }
        }
    }
};
struct EpiQKV {
    EpiPlain q; EpiKV kv;
    __device__ __forceinline__ void operator()(const Acc& acc, const Unit& un, int wr, int wc, int fr, int fq) const {
        if (un.pn < 3) q(acc, un, wr, wc, fr, fq); else { Unit v = un; v.pn = un.pn - 3; kv(acc, v, wr, wc, fr, fq); }
    }
};
struct EpiY {
    EpiMulGate yb; EpiMerge ya;
    __device__ __forceinline__ void operator()(const Acc& acc, const Unit& un, int wr, int wc, int fr, int fq) const {
        if (un.e == 0) yb(acc, un, wr, wc, fr, fq); else ya(acc, un, wr, wc, fr, fq);
    }
};
struct EpiResid {
    const bf16_t* xb; const float* rstd1; bf16_t* x1b;
    __device__ __forceinline__ void operator()(const Acc& acc, const Unit& un, int wr, int wc, int fr, int fq) const {
        const int row0 = un.pm * BM + wr * 64 + fr, c8 = un.pn * BM + wc * 32 + 8 * fq;
#pragma unroll
        for (int ai = 0; ai < 2; ++ai) {
            u32x4 X[4][2]; float iv[4];
#pragma unroll
            for (int m = 0; m < 4; ++m) iv[m] = rstd1[row0 + ai * HALF + m * 16];
#pragma unroll
            for (int m = 0; m < 4; ++m) { const size_t r = (size_t)(row0 + ai * HALF + m * 16);
#pragma unroll
                for (int bj = 0; bj < 2; ++bj) X[m][bj] = *(const u32x4*)(xb + r * 1024 + c8 + bj * HALF); }
#pragma unroll
            for (int m = 0; m < 4; ++m) { const size_t r = (size_t)(row0 + ai * HALF + m * 16);
#pragma unroll
                for (int bj = 0; bj < 2; ++bj) { const u32x4 w = X[m][bj];
                    const f32x4 x0 = (f32x4){bf_lo(w.x), bf_hi(w.x), bf_lo(w.y), bf_hi(w.y)}, x1 = (f32x4){bf_lo(w.z), bf_hi(w.z), bf_lo(w.w), bf_hi(w.w)};
                    const float inv = __builtin_amdgcn_rcpf(iv[m]);
                    store8(x1b + r * 1024 + c8 + bj * HALF, acc[ai][bj][m][0] + x0 * inv, acc[ai][bj][m][1] + x1 * inv); } }
        }
    }
};
struct EpiGU {
    const int* ltok; const float* lw; const float* rstd2; bf16_t* mid;
    __device__ __forceinline__ void operator()(const Acc& acc, const Unit& un, int wr, int wc, int fr, int fq) const {
        const int c8 = un.pn * 128 + wc * 32 + 8 * fq;
        const __amdgpu_buffer_rsrc_t rsrc = __builtin_amdgcn_make_buffer_rsrc((void*)mid, 0, 0x7fffffff, 0x00020000);
        int tk[8]; float w[8], rs[8];
#pragma unroll
        for (int q = 0; q < 8; ++q) { const int rl = (q >> 2) * HALF + wr * 64 + (q & 3) * 16 + fr; const bool valid = rl < un.nv; const size_t li = (size_t)un.e * CAP + un.r0 + rl;
            tk[q] = valid ? ltok[li] : 0; w[q] = valid ? lw[li] : 0.f; }
#pragma unroll
        for (int q = 0; q < 8; ++q) rs[q] = rstd2[tk[q] >> 1];
#pragma unroll
        for (int q = 0; q < 8; ++q) { const int ai = q >> 2, m = q & 3, rl = ai * HALF + wr * 64 + m * 16 + fr;
            f32x4 o[2];
#pragma unroll
            for (int n = 0; n < 2; ++n)
#pragma unroll
                for (int i = 0; i < 4; ++i) { const float a = acc[ai][0][m][n][i] * rs[q], up = acc[ai][1][m][n][i] * rs[q]; o[n][i] = a * sigmoidf_(a) * up * w[q]; }
            u32x4 wv_; wv_.x = cvt_pk_bf16(o[0][0], o[0][1]); wv_.y = cvt_pk_bf16(o[0][2], o[0][3]); wv_.z = cvt_pk_bf16(o[1][0], o[1][1]); wv_.w = cvt_pk_bf16(o[1][2], o[1][3]);
            __builtin_amdgcn_raw_buffer_store_b128(wv_, rsrc, (int)((((unsigned)un.pm * BM + rl) * EFF + c8) * 2u), 0, 16); }
    }
};
struct EpiDown {
    const int* ltok; unsigned char* y;
    __device__ __forceinline__ void operator()(const Acc& acc, const Unit& un, int wr, int wc, int fr, int fq) const {
        const int c16 = un.pn * BM + wc * 32 + 8 * (fq & ~1), odd = fq & 1;
#pragma unroll
        for (int qp = 0; qp < 4; ++qp) { const int ai = qp >> 1, m = (qp & 1) * 2;
            const int rl = ai * HALF + wr * 64 + (m + odd) * 16 + fr; const int t = rl < un.nv ? ltok[(size_t)un.e * CAP + un.r0 + rl] : -1;
            unsigned char* dst = y + ((size_t)(t & 1) * NTOK + (t >> 1)) * DM + c16;
#pragma unroll
            for (int bj = 0; bj < 2; ++bj) { const u32x4 w = pair16(pack8_fp8(acc[ai][bj][m][0], acc[ai][bj][m][1], Y_SC), pack8_fp8(acc[ai][bj][m + 1][0], acc[ai][bj][m + 1][1], Y_SC));
                if (t >= 0) *(u32x4*)(dst + bj * HALF) = w; } }
    }
};
struct EpiMoe {
    EpiGU gu; EpiDown dn;
    __device__ __forceinline__ void operator()(const Acc& acc, const Unit& un, int wr, int wc, int fr, int fq) const {
        if (un.kind == 0) gu(acc, un, wr, wc, fr, fq); else dn(acc, un, wr, wc, fr, fq);
    }
};
}

namespace att {
constexpr int DQK = 96, DV = 64, NW = 8, QBLK = 32, KVBLK = 64;
constexpr float SCALE = 0.10206207261596575f;
constexpr float THR = 8.f;
constexpr int KSLOT = 12288, VSLOT = 8192, NSLOT = 4, LDS_K = 0, LDS_V = NSLOT * KSLOT, LDS_WS = LDS_V + NSLOT * VSLOT, LDS_W = LDS_WS + NW * 64 * 4, SHM_ATTN = LDS_W + 96 * 512;
#define SBAR() __builtin_amdgcn_sched_barrier(0)
__device__ __forceinline__ int crow(int r, int hi) { return (r & 3) + 8 * (r >> 2) + 4 * hi; }
constexpr float THR2 = 8.f;
__device__ __forceinline__ void partialSM(f32x16& p0, f32x16& p1, float& m_reg, f32x16& negm, float& alpha) {
    float pmax = fmaxf(fmaxf(p0[0], p0[1]), p1[0]);
#pragma unroll
    for (int r = 2; r < 16; ++r) pmax = fmaxf(pmax, p0[r]);
#pragma unroll
    for (int r = 1; r < 16; ++r) pmax = fmaxf(pmax, p1[r]);
    { auto rr = __builtin_amdgcn_permlane32_swap(__float_as_uint(pmax), __float_as_uint(pmax), false, false);
      pmax = fmaxf(__uint_as_float(rr[0]), __uint_as_float(rr[1])); }
    if (__builtin_expect(__all(pmax <= THR2), 1)) { alpha = 1.f; }
    else { const float d = fmaxf(pmax, 0.f); m_reg += d; alpha = __builtin_amdgcn_exp2f(-d);
#pragma unroll
        for (int r = 0; r < 16; ++r) { p0[r] -= d; p1[r] -= d; }
#pragma unroll
        for (int r = 0; r < 16; ++r) negm[r] = -m_reg; }
#pragma unroll
    for (int r = 0; r < 16; ++r) p0[r] = __builtin_amdgcn_exp2f(p0[r]);
}
__device__ __forceinline__ void startSM(f32x16& p0, f32x16& p1, float& m_reg, f32x16& negm) {
    float pmax = fmaxf(fmaxf(p0[0], p0[1]), p1[0]);
#pragma unroll
    for (int r = 2; r < 16; ++r) pmax = fmaxf(pmax, p0[r]);
#pragma unroll
    for (int r = 1; r < 16; ++r) pmax = fmaxf(pmax, p1[r]);
    { auto rr = __builtin_amdgcn_permlane32_swap(__float_as_uint(pmax), __float_as_uint(pmax), false, false);
      pmax = fmaxf(__uint_as_float(rr[0]), __uint_as_float(rr[1])); }
    m_reg = pmax;
#pragma unroll
    for (int r = 0; r < 16; ++r) { p0[r] -= pmax; p1[r] -= pmax; negm[r] = -pmax; }
#pragma unroll
    for (int r = 0; r < 16; ++r) p0[r] = __builtin_amdgcn_exp2f(p0[r]);
}
__device__ __forceinline__ void finishSM(f32x16& p0, f32x16& p1, float alpha, float& l_reg, bf16x8& pa0, bf16x8& pa1, bf16x8& pa2, bf16x8& pa3) {
#pragma unroll
    for (int r = 0; r < 16; ++r) p1[r] = __builtin_amdgcn_exp2f(p1[r]);
    float ps = 0;
#pragma unroll
    for (int r = 0; r < 16; ++r) ps += p0[r];
#pragma unroll
    for (int r = 0; r < 16; ++r) ps += p1[r];
    { auto rr = __builtin_amdgcn_permlane32_swap(__float_as_uint(ps), __float_as_uint(ps), false, false);
      ps = __uint_as_float(rr[0]) + __uint_as_float(rr[1]); }
    l_reg = l_reg * alpha + ps;
#define PK4(P, BASE, OUT) do { unsigned a0 = cvt_pk_bf16(P[BASE + 0], P[BASE + 1]), a1 = cvt_pk_bf16(P[BASE + 2], P[BASE + 3]);   \
    unsigned b0 = cvt_pk_bf16(P[BASE + 4], P[BASE + 5]), b1 = cvt_pk_bf16(P[BASE + 6], P[BASE + 7]);                              \
    auto r0 = __builtin_amdgcn_permlane32_swap(a0, b0, false, false); auto r1 = __builtin_amdgcn_permlane32_swap(a1, b1, false, false); \
    u32x4 w = {r0[0], r1[0], r0[1], r1[1]}; OUT = *reinterpret_cast<bf16x8*>(&w); } while (0)
    PK4(p0, 0, pa0); PK4(p0, 8, pa1); PK4(p1, 0, pa2); PK4(p1, 8, pa3);
#undef PK4
}
__device__ __forceinline__ void qkt(f32x16& p0, f32x16& p1, const char* Ks, const bf16x8* qr, const f32x16& negm, int r32, int hi) {
    const int sw = (r32 >> 2) & 3; const char* kb = Ks + r32 * 192;
#pragma unroll
    for (int d0 = 0; d0 < 6; ++d0) { const int co = ((d0 * 2 + hi) ^ sw) << 4;
        const bf16x8 b0 = *reinterpret_cast<const bf16x8*>(kb + co);
        const bf16x8 b1 = *reinterpret_cast<const bf16x8*>(kb + 32 * 192 + co);
        p0 = __builtin_amdgcn_mfma_f32_32x32x16_bf16(b0, qr[d0], d0 == 0 ? negm : p0, 0, 0, 0);
        p1 = __builtin_amdgcn_mfma_f32_32x32x16_bf16(b1, qr[d0], d0 == 0 ? negm : p1, 0, 0, 0); }
}
__device__ __forceinline__ int v_rd_base(int lane) { return ((lane & 3) << 3) | (((lane >> 2) & 3) << 6) | (((lane >> 4) & 1) << 5) | (((lane >> 5) & 1) << 8); }
constexpr int v_rd_off(int d0, int ks, int half) { return d0 * 512 + ks * 2048 + half * 1024; }
template <int OFF> __device__ __forceinline__ s16x4 tr_read(int vb) {
    s16x4 r; asm volatile("ds_read_b64_tr_b16 %0, %1 offset:%2" : "=&v"(r) : "v"(vb), "i"(OFF) : "memory"); return r;
}
template <int D0> __device__ __forceinline__ void pv_one(f32x16& od, int vb, bf16x8 pa0, bf16x8 pa1, bf16x8 pa2, bf16x8 pa3) {
    const s16x4 l0 = tr_read<v_rd_off(D0, 0, 0)>(vb), h0 = tr_read<v_rd_off(D0, 0, 1)>(vb), l1 = tr_read<v_rd_off(D0, 1, 0)>(vb), h1 = tr_read<v_rd_off(D0, 1, 1)>(vb);
    const s16x4 l2 = tr_read<v_rd_off(D0, 2, 0)>(vb), h2 = tr_read<v_rd_off(D0, 2, 1)>(vb), l3 = tr_read<v_rd_off(D0, 3, 0)>(vb), h3 = tr_read<v_rd_off(D0, 3, 1)>(vb);
    asm volatile("s_waitcnt lgkmcnt(0)" ::: "memory"); SBAR();
#define PK(L, H) (bf16x8){L[0], L[1], L[2], L[3], H[0], H[1], H[2], H[3]}
    od = __builtin_amdgcn_mfma_f32_32x32x16_bf16(pa0, PK(l0, h0), od, 0, 0, 0);
    od = __builtin_amdgcn_mfma_f32_32x32x16_bf16(pa1, PK(l1, h1), od, 0, 0, 0);
    od = __builtin_amdgcn_mfma_f32_32x32x16_bf16(pa2, PK(l2, h2), od, 0, 0, 0);
    od = __builtin_amdgcn_mfma_f32_32x32x16_bf16(pa3, PK(l3, h3), od, 0, 0, 0);
#undef PK
}
__device__ __forceinline__ void pv_d0(f32x16* o, int vb, bf16x8 pa0, bf16x8 pa1, bf16x8 pa2, bf16x8 pa3) {
    pv_one<0>(o[0], vb, pa0, pa1, pa2, pa3); pv_one<1>(o[1], vb, pa0, pa1, pa2, pa3);
}
template <int BASE> __device__ __forceinline__ bf16x8 pk4(const f32x16& P) {
    const unsigned a0 = cvt_pk_bf16(P[BASE + 0], P[BASE + 1]), a1 = cvt_pk_bf16(P[BASE + 2], P[BASE + 3]), b0 = cvt_pk_bf16(P[BASE + 4], P[BASE + 5]), b1 = cvt_pk_bf16(P[BASE + 6], P[BASE + 7]);
    auto r0 = __builtin_amdgcn_permlane32_swap(a0, b0, false, false); auto r1 = __builtin_amdgcn_permlane32_swap(a1, b1, false, false);
    u32x4 w = {r0[0], r1[0], r0[1], r1[1]}; return __builtin_bit_cast(bf16x8, w);
}
__device__ __forceinline__ void attn_unit(const bf16_t* __restrict__ qd, const bf16_t* __restrict__ Wimg, const float* __restrict__ cstab, const float* __restrict__ gq,
                                          const bf16_t* __restrict__ Kimg, const bf16_t* __restrict__ Vimg, bf16_t* __restrict__ Ob, int NT, char* lds, LAS unsigned char* L, const int wave_, const bool first, const bool has_next) {
    const int wid = wave_, lane = lane_id_fresh(), r32 = lane & 31, hi = lane >> 5;
    char* V_lds = lds + LDS_V; char* K_lds = lds + LDS_K;
    float* ws = (float*)(lds + LDS_WS) + wid * 64; float* li_l = ws; float* al_l = ws + 32;
    float m_reg = 0.f, l_reg = 0; f32x16 o[2] = {}; bf16x8 qr[6];
    const int jmax = NT - 4 + (wid >> 1);
    const char* ksrc = (const char*)Kimg + wid * 1024 + lane * 16; const char* vsrc = (const char*)Vimg + wid * 1024 + lane * 16;
#define DMA_TILE(j, slot) do { __builtin_amdgcn_global_load_lds((const unsigned*)(ksrc + (size_t)(j) * KSLOT), (LAS unsigned*)(L + LDS_K + (slot) * KSLOT + wid * 1024), 16, 0, 0); \
        if (wid < 4) __builtin_amdgcn_global_load_lds((const unsigned*)(ksrc + (size_t)(j) * KSLOT + 8192), (LAS unsigned*)(L + LDS_K + (slot) * KSLOT + 8192 + wid * 1024), 16, 0, 0); \
        __builtin_amdgcn_global_load_lds((const unsigned*)(vsrc + (size_t)(j) * VSLOT), (LAS unsigned*)(L + LDS_V + (slot) * VSLOT + wid * 1024), 16, 0, 0); } while (0)
#define WAIT_NEXT() do { if (wid < 4) asm volatile("s_waitcnt vmcnt(3)" ::: "memory"); else asm volatile("s_waitcnt vmcnt(2)" ::: "memory"); } while (0)
#define BAR() do { asm volatile("s_waitcnt lgkmcnt(0)" ::: "memory"); __builtin_amdgcn_s_barrier(); asm volatile("" ::: "memory"); } while (0)
    if (first) {
#pragma unroll
        for (int i = 0; i < 6; ++i) __builtin_amdgcn_global_load_lds((const unsigned*)((const char*)Wimg + (wid + 8 * i) * 1024 + lane * 16), (LAS unsigned*)(L + LDS_W + (wid + 8 * i) * 1024), 16, 0, 0);
        DMA_TILE(0, 0); DMA_TILE(1, 1);
    }
    {
        const int qrow = wid * QBLK + r32;
        const bf16_t* qp = qd + (long)qrow * 512 + hi * 8;
        bf16x8 bq[16]; float ssq = 0.f;
#pragma unroll
        for (int ks = 0; ks < 16; ++ks) bq[ks] = *reinterpret_cast<const bf16x8*>(qp + ks * 16);
#pragma unroll
        for (int ks = 0; ks < 16; ++ks) { const u32x4 w = __builtin_bit_cast(u32x4, bq[ks]);
            const float a0 = bf_lo(w.x), a1 = bf_hi(w.x), a2 = bf_lo(w.y), a3 = bf_hi(w.y), a4 = bf_lo(w.z), a5 = bf_hi(w.z), a6 = bf_lo(w.w), a7 = bf_hi(w.w);
            ssq += (a0 * a0 + a1 * a1) + (a2 * a2 + a3 * a3) + (a4 * a4 + a5 * a5) + (a6 * a6 + a7 * a7); }
        ssq += __shfl_xor(ssq, 32);
        asm volatile("s_waitcnt vmcnt(0)" ::: "memory"); BAR();
        f32x16 qa[3]; qa[0] = f32x16{}; qa[1] = f32x16{}; qa[2] = f32x16{};
        const char* wl = lds + LDS_W + r32 * 512;
#pragma unroll
        for (int ks = 0; ks < 16; ++ks) { const int co = ((2 * ks + hi) ^ r32) << 4;
#pragma unroll
            for (int db = 0; db < 3; ++db) { const bf16x8 a = *reinterpret_cast<const bf16x8*>(wl + db * 32 * 512 + co); qa[db] = __builtin_amdgcn_mfma_f32_32x32x16_bf16(a, bq[ks], qa[db], 0, 0, 0); } }
        const float rq = 1.0f / sqrtf(ssq * (1.f / 256.f) + 1e-6f);
        float ss = 0.f;
#pragma unroll
        for (int db = 0; db < 3; ++db)
#pragma unroll
            for (int r = 0; r < 16; ++r) { qa[db][r] *= rq; ss += qa[db][r] * qa[db][r]; }
        ss += __shfl_xor(ss, 32);
        const float rn = 1.0f / sqrtf(ss * (1.f / 96.f) + 1e-6f);
#pragma unroll
        for (int db = 0; db < 3; ++db)
#pragma unroll
            for (int g4 = 0; g4 < 4; ++g4) { const f32x4 g = *(const f32x4*)(gq + 32 * db + 8 * g4 + 4 * hi);
#pragma unroll
                for (int i = 0; i < 4; ++i) qa[db][4 * g4 + i] *= g[i] * (rn * (SCALE * 1.4426950408889634f)); }
        const float* cs = cstab + (long)qrow * 32 + 4 * hi;
        const f32x4 c0 = *(const f32x4*)cs, c1 = *(const f32x4*)(cs + 8), s0 = *(const f32x4*)(cs + 16), s1 = *(const f32x4*)(cs + 24);
#pragma unroll
        for (int i = 0; i < 4; ++i) {
            const float xa = qa[2][i], xb_ = qa[2][8 + i], ya = qa[2][4 + i], yb = qa[2][12 + i];
            qa[2][i] = xa * c0[i] - xb_ * s0[i]; qa[2][8 + i] = xb_ * c0[i] + xa * s0[i];
            qa[2][4 + i] = ya * c1[i] - yb * s1[i]; qa[2][12 + i] = yb * c1[i] + ya * s1[i]; }
        qr[0] = pk4<0>(qa[0]); qr[1] = pk4<8>(qa[0]); qr[2] = pk4<0>(qa[1]); qr[3] = pk4<8>(qa[1]); qr[4] = pk4<0>(qa[2]); qr[5] = pk4<8>(qa[2]);
    }
    const int vb0 = (int)(uintptr_t)V_lds + v_rd_base(lane);
#define RESC(a) do { if (__any((a) < 1.f)) { if (hi == 0) al_l[r32] = (a); asm volatile("s_waitcnt lgkmcnt(0)" ::: "memory"); \
    _Pragma("unroll") for (int d = 0; d < 2; ++d) _Pragma("unroll") for (int r = 0; r < 16; ++r) o[d][r] *= al_l[crow(r, hi)]; } } while (0)
    f32x16 pA0, pA1, pB0, pB1; float alA = 1.f, alB = 1.f; bf16x8 pa0, pa1, pa2, pa3; f32x16 negm = f32x16{};
    WAIT_NEXT(); BAR(); DMA_TILE(2, 2);
    qkt(pA0, pA1, K_lds, qr, negm, r32, hi); startSM(pA0, pA1, m_reg, negm);
    for (int t = 1; t + 1 < NT; t += 2) {
        WAIT_NEXT(); BAR(); DMA_TILE(t + 2, (t + 2) & 3);
        if (t - 1 <= jmax) {
            SBAR(); if (t <= jmax) qkt(pB0, pB1, K_lds + (t & 3) * KSLOT, qr, negm, r32, hi);
            finishSM(pA0, pA1, alA, l_reg, pa0, pa1, pa2, pa3); SBAR();
            pv_d0(o, vb0 + ((t - 1) & 3) * VSLOT, pa0, pa1, pa2, pa3);
            if (t <= jmax) { partialSM(pB0, pB1, m_reg, negm, alB); RESC(alB); }
        }
        WAIT_NEXT(); BAR(); if (t + 3 < NT) DMA_TILE(t + 3, (t + 3) & 3);
        if (t <= jmax) {
            SBAR(); if (t + 1 <= jmax) qkt(pA0, pA1, K_lds + ((t + 1) & 3) * KSLOT, qr, negm, r32, hi);
            finishSM(pB0, pB1, alB, l_reg, pa0, pa1, pa2, pa3); SBAR();
            pv_d0(o, vb0 + (t & 3) * VSLOT, pa0, pa1, pa2, pa3);
            if (t + 1 <= jmax) { partialSM(pA0, pA1, m_reg, negm, alA); RESC(alA); }
        }
    }
    asm volatile("s_waitcnt vmcnt(0)" ::: "memory"); BAR();
    if (has_next) { DMA_TILE(0, 0); DMA_TILE(1, 1); }
    if (NT - 2 <= jmax) {
        SBAR(); if (NT - 1 <= jmax) qkt(pB0, pB1, K_lds + ((NT - 1) & 3) * KSLOT, qr, negm, r32, hi);
        finishSM(pA0, pA1, alA, l_reg, pa0, pa1, pa2, pa3); SBAR();
        pv_d0(o, vb0 + ((NT - 2) & 3) * VSLOT, pa0, pa1, pa2, pa3);
        if (NT - 1 <= jmax) { partialSM(pB0, pB1, m_reg, negm, alB); RESC(alB);
            finishSM(pB0, pB1, alB, l_reg, pa0, pa1, pa2, pa3); SBAR();
            pv_d0(o, vb0 + ((NT - 1) & 3) * VSLOT, pa0, pa1, pa2, pa3); }
    }
    if (hi == 0) li_l[r32] = l_reg; asm volatile("s_waitcnt lgkmcnt(0)" ::: "memory");
    float rli[16];
#pragma unroll
    for (int r = 0; r < 16; ++r) rli[r] = __builtin_amdgcn_rcpf(li_l[crow(r, hi)]);
    bf16_t* Ow = Ob + (long)(wid * QBLK) * 512;
#pragma unroll
    for (int r = 0; r < 16; ++r) { const int orow = crow(r, hi);
#pragma unroll
        for (int d0 = 0; d0 < 2; ++d0) Ow[(long)orow * 512 + d0 * 32 + r32] = (bf16_t)(cvt_pk_bf16(o[d0][r] * rli[r], 0.f) & 0xffffu); }
    if (!has_next) BAR();
#undef DMA_TILE
#undef WAIT_NEXT
#undef BAR
#undef RESC
}
#undef SBAR
}

__device__ __forceinline__ void tr_item(const float* W, int ldw, int src_col, bf16_t* WT, int ldk, int dst_row, int k0, const float* gain, LAS float* scr, int lane) {
    const int c = lane & 7;
    if (src_col < 0) {
#pragma unroll
        for (int j = 0; j < 4; ++j) { const int n = (lane >> 3) + 8 * j; *(u32x4*)(WT + (size_t)(dst_row + n) * ldk + k0 + 8 * c) = (u32x4){0u, 0u, 0u, 0u}; }
        return;
    }
    f32x4 v[8];
#pragma unroll
    for (int j = 0; j < 8; ++j) v[j] = *(const f32x4*)(W + (size_t)(k0 + (lane >> 3) + 8 * j) * ldw + src_col + 4 * c);
    if (gain) {
#pragma unroll
        for (int j = 0; j < 8; ++j) v[j] = v[j] * gain[k0 + (lane >> 3) + 8 * j];
    }
#pragma unroll
    for (int j = 0; j < 8; ++j) { LAS float* d = scr + ((lane >> 3) + 8 * j) * 33 + 4 * c; d[0] = v[j][0]; d[1] = v[j][1]; d[2] = v[j][2]; d[3] = v[j][3]; }
    LDS_WAIT(); asm volatile("" ::: "memory");
#pragma unroll
    for (int j = 0; j < 4; ++j) { const int n = (lane >> 3) + 8 * j; const LAS float* s = scr + (8 * c) * 33 + n;
        u32x4 o; o.x = cvt_pk_bf16(s[0 * 33], s[1 * 33]); o.y = cvt_pk_bf16(s[2 * 33], s[3 * 33]); o.z = cvt_pk_bf16(s[4 * 33], s[5 * 33]); o.w = cvt_pk_bf16(s[6 * 33], s[7 * 33]);
        *(u32x4*)(WT + (size_t)(dst_row + n) * ldk + k0 + 8 * c) = o; }
    LDS_WAIT(); asm volatile("" ::: "memory");
}

__device__ __forceinline__ void tr_item8(const float* W, int ldw, int src_col, unsigned char* WT8, int ldk, int dst_row, int k0, const float* gain, float sc, LAS float* scr, int lane) {
    const int c = lane & 7;
    f32x4 v[8];
#pragma unroll
    for (int j = 0; j < 8; ++j) v[j] = *(const f32x4*)(W + (size_t)(k0 + (lane >> 3) + 8 * j) * ldw + src_col + 4 * c);
#pragma unroll
    for (int j = 0; j < 8; ++j) v[j] = v[j] * (gain[k0 + (lane >> 3) + 8 * j] * sc);
#pragma unroll
    for (int j = 0; j < 8; ++j) { LAS float* d = scr + ((lane >> 3) + 8 * j) * 33 + 4 * c; d[0] = v[j][0]; d[1] = v[j][1]; d[2] = v[j][2]; d[3] = v[j][3]; }
    LDS_WAIT(); asm volatile("" ::: "memory");
    const int c4 = lane & 3;
#pragma unroll
    for (int j = 0; j < 2; ++j) { const int n = (lane >> 2) + 16 * j; const LAS float* s = scr + (16 * c4) * 33 + n;
        const u32x2 lo = pack8_fp8((f32x4){s[0 * 33], s[1 * 33], s[2 * 33], s[3 * 33]}, (f32x4){s[4 * 33], s[5 * 33], s[6 * 33], s[7 * 33]}, 1.f);
        const u32x2 hi = pack8_fp8((f32x4){s[8 * 33], s[9 * 33], s[10 * 33], s[11 * 33]}, (f32x4){s[12 * 33], s[13 * 33], s[14 * 33], s[15 * 33]}, 1.f);
        *(u32x4*)(WT8 + (size_t)(dst_row + n) * ldk + k0 + 16 * c4) = (u32x4){lo.x, lo.y, hi.x, hi.y}; }
    LDS_WAIT(); asm volatile("" ::: "memory");
}

#ifndef DBG_STOP
#define DBG_STOP 0
#endif
constexpr size_t WS_DBG = 448 * MiB;
struct Args { const void* in[26]; float* out; unsigned char* ws; int mask, pad; };

__global__ void __launch_bounds__(NTHR, 2) mk_fwd(Args args) {
    extern __shared__ __attribute__((aligned(16))) unsigned char lds[];
    LAS unsigned char* L = (LAS unsigned char*)lds;
    volatile LAS unsigned* MISC = (volatile LAS unsigned*)(L + MISC_OFF);
    const int wave = __builtin_amdgcn_readfirstlane((int)threadIdx.x >> 6);
    const int G = gridDim.x, bx = blockIdx.x;
    const int gw = bx * NWAVES + wave, NGW = G * NWAVES;
    unsigned char* ws = args.ws;
    const float* x = (const float*)args.in[0]; const int* positions = (const int*)args.in[1];
    const float* g_mix = (const float*)args.in[2]; const float* w_in = (const float*)args.in[3];
    const float* g_q_lora = (const float*)args.in[4]; const float* w_uq = (const float*)args.in[5];
    const float* g_kv_lora = (const float*)args.in[6]; const float* w_ukv = (const float*)args.in[7];
    const float* g_qk_q = (const float*)args.in[8]; const float* g_qk_k = (const float*)args.in[9];
    const float* w_o_mla = (const float*)args.in[10]; const float* w_dw = (const float*)args.in[11]; const float* b_dw = (const float*)args.in[12];
    const float* g_conv_ln = (const float*)args.in[13]; const float* b_conv_ln = (const float*)args.in[14]; const float* w_conv_out = (const float*)args.in[15];
    const float* b_gates = (const float*)args.in[16]; const float* w_out = (const float*)args.in[17]; const float* g_ffn = (const float*)args.in[18];
    const float* w_gr = (const float*)args.in[19]; const float* b_gr = (const float*)args.in[20]; const float* w_er = (const float*)args.in[21]; const float* b_er = (const float*)args.in[22];
    const float* w_eg = (const float*)args.in[23]; const float* w_eu = (const float*)args.in[24]; const float* w_ed = (const float*)args.in[25];
    float* out = args.out;
    unsigned* ctl = (unsigned*)(ws + WS_CTL);
    float* rstd2 = (float*)(ws + WS_RSTD2);
    bf16_t* WrB = (bf16_t*)(ws + WS_WRB);
    bf16_t* Wt_in = (bf16_t*)(ws + WS_WIN); bf16_t* Wq_img = (bf16_t*)(ws + WS_WQIMG); bf16_t* Wt_ukv = (bf16_t*)(ws + WS_WUKV); float* rstd1 = (float*)(ws + WS_RSTD1);
    bf16_t* Wt_o = (bf16_t*)(ws + WS_WO); bf16_t* Wt_c = (bf16_t*)(ws + WS_WC); bf16_t* Wt_out = (bf16_t*)(ws + WS_WOUT);
    bf16_t* Wt_gu = (bf16_t*)(ws + WS_WGU); bf16_t* Wt_d = (bf16_t*)(ws + WS_WD);
    bf16_t* xb = (bf16_t*)(ws + WS_A); bf16_t* attn = (bf16_t*)(ws + WS_T + 16 * MiB); bf16_t* x1b = (bf16_t*)(ws + WS_G);
    bf16_t* qkvd = (bf16_t*)(ws + WS_B); bf16_t* ubuf = (bf16_t*)(ws + WS_B + 32 * MiB); unsigned char* mb = (unsigned char*)(ws + WS_B);
    int* ltok = (int*)(ws + WS_B); float* lw = (float*)(ws + WS_B + 4 * MiB); bf16_t* mid = (bf16_t*)(ws + WS_B + 8 * MiB);
    bf16_t* Vg = (bf16_t*)(ws + WS_C); bf16_t* merged = (bf16_t*)(ws + WS_C);
    bf16_t* ub = (bf16_t*)(ws + WS_D); unsigned char* ybuf = (unsigned char*)(ws + WS_D);
    bf16_t* Kg = (bf16_t*)(ws + WS_E);
    float* cstab = (float*)(ws + WS_T); bf16_t* krr = (bf16_t*)(ws + WS_T + 4 * MiB);
    float* ssq_kv = (float*)(ws + WS_T + 8 * MiB); float* ssq_rope = ssq_kv + 4 * NTOK;
    unsigned char* xb8 = ws + WS_XB8; unsigned char* Wt_in8 = ws + WS_XB8 + 32 * MiB;
    unsigned char* gates = (unsigned char*)(ws + WS_G);
    unsigned* gcnt = ctl + CW_CNT;

    { const int tid = wave * 64 + lane_id_fresh(); for (int u = tid; u < 1024; u += NTHR) MISC[u] = 0u; }
    __syncthreads();
    XcdBarrier bar = xcd_barrier_post(ctl + CW_BAR, MISC + 8);
#ifndef USE_CG
#define USE_CG 0
#endif
#if USE_CG
    cooperative_groups::grid_group cg_grid = cooperative_groups::this_grid();
#define GRID_BAR() do { __threadfence(); cg_grid.sync(); } while (0)
#else
#define GRID_BAR() xcd_barrier(bar)
#endif
#define DBG_FINISH() do { GRID_BAR(); { const int tid_ = wave * 64 + lane_id_fresh(); const bf16_t* dbg_ = (const bf16_t*)(ws + WS_DBG); \
        for (size_t i = (size_t)bx * NTHR + tid_; i < (size_t)NTOK * DM / 8; i += (size_t)G * NTHR) { f32x4 a0, a1; load8(dbg_ + i * 8, a0, a1); f32x4* o = (f32x4*)(out + i * 8); o[0] = a0; o[1] = a1; } } return; } while (0)
#define DBG_PROBE(expr) do { GRID_BAR(); { const int tid_ = wave * 64 + lane_id_fresh(); bf16_t* dbg_ = (bf16_t*)(ws + WS_DBG); \
        for (size_t i = (size_t)bx * NTHR + tid_; i < (size_t)NTOK * DM; i += (size_t)G * NTHR) { const size_t t = i >> 10; const int c = (int)(i & 1023); (void)t; (void)c; \
            const float v = (expr); dbg_[i] = (bf16_t)(cvt_pk_bf16(v, 0.f) & 0xffffu); } } DBG_FINISH(); } while (0)

    if (args.mask & (1 << 0)) {
    {
        const int lane = lane_id_fresh(), tid = wave * 64 + lane; (void)tid; (void)lane;
        LAS float* scr = (LAS float*)(L + wave * 16384);
        constexpr int I_IN8 = 64 * 16;
        constexpr int I_IN = 48 * 16, I_UQ = 24 * 4, I_UKV = 32 * 2, I_O = 32 * 8, I_C = 32 * 8, I_OUT = 32 * 16, I_GU = 32 * 16 * 16, I_D = 32 * 32 * 4;
        constexpr int NITEMS = I_IN + I_UQ + I_UKV + I_O + I_C + I_OUT + I_GU + I_D + I_IN8;
        for (int it = gw; it < NITEMS; it += NGW) {
            int r = it;
            if (r < I_IN) { const int rg = r / 16, kb = r % 16, row = rg * 32; int src;
                if (row < 416) src = row; else if (row < 512) src = -1;
                else if (row < 1536) { const int t = (row - 512) / 256, rr = (row - 512) % 256; src = rr < 128 ? 416 + 128 * t + rr : 416 + 512 + 128 * t + (rr - 128); }
                else src = 1440 + (row - 1536);
                tr_item(w_in, INC, src, Wt_in, 1024, row, kb * 64, g_mix, scr, lane); continue; } r -= I_IN;
            if (r < I_UQ) { continue; } r -= I_UQ;
            if (r < I_UKV) { const int rg = r / 2, kb = r % 2, pn_ = rg / 8, q_ = rg % 8, bj_ = q_ / 4, wc_ = q_ % 4;
                const int srcc = (2 * pn_ + (wc_ & 1)) * 128 + (wc_ >> 1) * 64 + 32 * bj_;
                tr_item(w_ukv, 1024, srcc, Wt_ukv, 128, rg * 32, kb * 64, g_kv_lora, scr, lane); continue; } r -= I_UKV;
            if (r < I_O) { const int rg = r / 8, kb = r % 8; tr_item(w_o_mla, 1024, rg * 32, Wt_o, 512, rg * 32, kb * 64, nullptr, scr, lane); continue; } r -= I_O;
            if (r < I_C) { const int rg = r / 8, kb = r % 8; tr_item(w_conv_out, 1024, rg * 32, Wt_c, 512, rg * 32, kb * 64, nullptr, scr, lane); continue; } r -= I_C;
            if (r < I_OUT) { const int rg = r / 16, kb = r % 16; tr_item(w_out, 1024, rg * 32, Wt_out, 1024, rg * 32, kb * 64, nullptr, scr, lane); continue; } r -= I_OUT;
            if (r < I_GU) { const int e = r / 256, q = r % 256, rg = q / 16, kb = q % 16, row = rg * 32, pn = row / 256, rr = row % 256;
                const float* src = (rr < 128 ? w_eg : w_eu) + (size_t)e * 1024 * 256; const int sc = 128 * pn + (rr & 127);
                tr_item(src, 256, sc, Wt_gu + (size_t)e * 512 * 1024, 1024, row, kb * 64, g_ffn, scr, lane); continue; } r -= I_GU;
            if (r < I_D) { const int e = r / 128, q = r % 128, rg = q / 4, kb = q % 4;
              tr_item(w_ed + (size_t)e * 256 * 1024, 1024, rg * 32, Wt_d + (size_t)e * 1024 * 256, 256, rg * 32, kb * 64, nullptr, scr, lane); continue; } r -= I_D;
            { const int rg = r / 16, kb = r % 16; tr_item8(w_in, INC, 1440 + rg * 32, Wt_in8, 1024, rg * 32, kb * 64, g_mix, 16.f, scr, lane); }
        }
        for (int p = bx * NTHR + tid; p < 2 * 16 * 3 * 64 * 8; p += G * NTHR) {
            const int j = p & 7, ln = (p >> 3) & 63, q = p >> 9, cf = q % 3, ks = (q / 3) % 16, kh = q / 48;
            const int k = kh * 512 + ks * 32 + 8 * (ln >> 4) + j, col = 16 * cf + (ln & 15);
            float w = 0.f; if (col < 4) w = w_gr[k * 4 + col]; else if (col < 36) w = w_er[k * 32 + (col - 4)];
            w *= g_ffn[k];
            const unsigned hb = cvt_pk_bf16(w, 0.f) & 0xffffu; const float lo = w - __uint_as_float(hb << 16);
            const unsigned lb = cvt_pk_bf16(lo, 0.f) & 0xffffu;
            const size_t base = ((size_t)((kh * 16 + ks) * 3 + cf) * 2) * 512 + ln * 8 + j;
            WrB[base] = (bf16_t)hb; WrB[base + 512] = (bf16_t)lb;
        }
        if (bx == 0 && tid < 32) gcnt[tid] = 0u;
        if (bx == 0 && tid < 320) ctl[CW_TCNT + tid] = 0u;
        for (int p = bx * NTHR + tid; p < 768 * 32; p += G * NTHR) {
            const int row = p >> 5, ch = p & 31, d = row % 96; float v[8];
#pragma unroll
            for (int j = 0; j < 8; ++j) v[j] = w_uq[(size_t)(8 * ch + j) * 768 + row] * g_q_lora[8 * ch + j];
            u32x4 o; o.x = cvt_pk_bf16(v[0], v[1]); o.y = cvt_pk_bf16(v[2], v[3]); o.z = cvt_pk_bf16(v[4], v[5]); o.w = cvt_pk_bf16(v[6], v[7]);
            *(u32x4*)(Wq_img + (size_t)row * 256 + ((ch ^ (d & 31)) << 3)) = o; }
        for (int p = bx * NTHR + tid; p < NTOK * 16; p += G * NTHR) {
            const int t = p >> 4, i = p & 15; const float invf = exp2f(-(float)i * (13.287712379549449f / 16.f));
            float sn, cs; sincosf((float)positions[t] * invf, &sn, &cs); cstab[t * 32 + i] = cs; cstab[t * 32 + 16 + i] = sn; }
        for (int m = gw; m < NTOK; m += 2 * NGW) {
            const int m2 = m + NGW;
            const f32x4* xr = (const f32x4*)(x + (size_t)m * DM) + lane; const f32x4* xr2 = (const f32x4*)(x + (size_t)(m2 < NTOK ? m2 : m) * DM) + lane;
            f32x4 v[4], w[4]; float s = 0.f, s2 = 0.f;
#pragma unroll
            for (int j = 0; j < 4; ++j) { v[j] = xr[64 * j]; w[j] = xr2[64 * j]; }
#pragma unroll
            for (int j = 0; j < 4; ++j) { s += (v[j][0] * v[j][0] + v[j][1] * v[j][1]) + (v[j][2] * v[j][2] + v[j][3] * v[j][3]); s2 += (w[j][0] * w[j][0] + w[j][1] * w[j][1]) + (w[j][2] * w[j][2] + w[j][3] * w[j][3]); }
            const float rs = 1.0f / sqrtf(wave_sum(s) * (1.f / DM) + EPS), rs2 = 1.0f / sqrtf(wave_sum(s2) * (1.f / DM) + EPS);
            u32x2* o8 = (u32x2*)(xb + (size_t)m * DM) + lane;
#pragma unroll
            for (int j = 0; j < 4; ++j) { u32x2 q; q.x = cvt_pk_bf16(v[j][0] * rs, v[j][1] * rs); q.y = cvt_pk_bf16(v[j][2] * rs, v[j][3] * rs); o8[64 * j] = q;
                int w8 = 0; w8 = __builtin_amdgcn_cvt_pk_fp8_f32(v[j][0] * rs, v[j][1] * rs, w8, false); w8 = __builtin_amdgcn_cvt_pk_fp8_f32(v[j][2] * rs, v[j][3] * rs, w8, true); ((int*)(xb8 + (size_t)m * DM))[lane + 64 * j] = w8; }
            if (lane == 0) { rstd1[m] = rs; if (m2 < NTOK) rstd1[m2] = rs2; }
            if (m2 < NTOK) { u32x2* o9 = (u32x2*)(xb + (size_t)m2 * DM) + lane;
#pragma unroll
                for (int j = 0; j < 4; ++j) { u32x2 q; q.x = cvt_pk_bf16(w[j][0] * rs2, w[j][1] * rs2); q.y = cvt_pk_bf16(w[j][2] * rs2, w[j][3] * rs2); o9[64 * j] = q;
                    int w8 = 0; w8 = __builtin_amdgcn_cvt_pk_fp8_f32(w[j][0] * rs2, w[j][1] * rs2, w8, false); w8 = __builtin_amdgcn_cvt_pk_fp8_f32(w[j][2] * rs2, w[j][3] * rs2, w8, true); ((int*)(xb8 + (size_t)m2 * DM))[lane + 64 * j] = w8; } }
        }
    }
    if (args.mask & ~(1 << 0)) GRID_BAR();
    }

    if (args.mask & (1 << 1)) {
    {
        { pg8::DenseSched S; S.init(xb, 1024, Wt_in, 1024, NTOK, 1536, G, bx); S.ntk = 16;
          pg8::EpiG1 E{qkvd, ubuf, gates, b_gates, rstd1, ssq_kv, ssq_rope, krr, cstab, g_qk_k};
          pg8::gemm_phase<pg8::EpiG1, pg8::DenseSched, true>(L, wave, 1024, S, E); }
        { pg8::DenseSched S; S.init((const bf16_t*)xb8, 512, (const bf16_t*)Wt_in8, 512, NTOK, 2048, G, bx); S.ntk = 8;
          pg8::EpiGates E{gates, b_gates};
          pg8::gemm_phase<pg8::EpiGates, pg8::DenseSched, true, true>(L, wave, 1024, S, E); }
    }
    if (args.mask & ~(1 << 1)) GRID_BAR();
    }

    if (args.mask & (1 << 2)) {
    {
        { pg8::DenseSched S; S.init(qkvd + 256, 512, Wt_ukv, 128, NTOK, 1024, G, bx); S.ntk = 2; pg8::EpiKV E{ssq_kv, ssq_rope, krr, g_qk_k, Kg, Vg};
          pg8::gemm_phase<pg8::EpiKV, pg8::DenseSched, true>(L, wave, 128, S, E); }
        const int lane = lane_id_fresh(), tid = wave * 64 + lane;
#define LBAR() do { asm volatile("s_waitcnt lgkmcnt(0)" ::: "memory"); __builtin_amdgcn_s_barrier(); asm volatile("" ::: "memory"); } while (0)
        LAS float* red = (LAS float*)(L + 131072);
        const int c2 = tid & 255, th = tid >> 8, wq = wave & 3;
        h16x2 wv[CONVK];
#pragma unroll
        for (int k = 0; k < CONVK; ++k) wv[k] = (h16x2){(_Float16)w_dw[k * CONVW + 2 * c2], (_Float16)w_dw[k * CONVW + 2 * c2 + 1]};
        const h16x2 bd = {(_Float16)b_dw[2 * c2], (_Float16)b_dw[2 * c2 + 1]};
        const float lg0 = g_conv_ln[2 * c2], lg1 = g_conv_ln[2 * c2 + 1], lb0 = b_conv_ln[2 * c2], lb1 = b_conv_ln[2 * c2 + 1];
        constexpr int NTILE = NBATCH * (SEQ / 32);
#define CONV_DMA(tile_, buf_) do { const int b_ = (tile_) / (SEQ / 32), t0_ = ((tile_) % (SEQ / 32)) * 32; const char* src_ = (const char*)(ubuf + ((long)b_ * SEQ + t0_ - 30) * CONVW) + lane * 16; \
            _Pragma("unroll") for (int i = 0; i < 8; ++i) __builtin_amdgcn_global_load_lds((const unsigned*)(src_ + (long)(wave + 8 * i) * 1024), (LAS unsigned*)(L + (buf_) * 65536 + (wave + 8 * i) * 1024), 16, 0, 0); } while (0)
        const int nper = (NTILE + G - 1) / G, tile_end = (bx * nper + nper < NTILE) ? bx * nper + nper : NTILE;
        LBAR();
        if (bx * nper < NTILE) CONV_DMA(bx * nper, 0);
        asm volatile("s_waitcnt vmcnt(0)" ::: "memory");
        int it = 0; unsigned yst[16]; size_t prow = 0;
#pragma unroll
        for (int o = 0; o < 16; ++o) yst[o] = 0u;
#pragma unroll 1
        for (int tile = bx * nper; tile < tile_end; ++tile, ++it) {
            const int b = tile / (SEQ / 32), t0 = (tile % (SEQ / 32)) * 32, buf = it & 1; const size_t rowbase = (size_t)b * SEQ + t0;
            asm volatile("s_waitcnt vmcnt(0)" ::: "memory");
            LBAR();
            if (it) {
#pragma unroll
                for (int o = 0; o < 16; ++o) *(unsigned*)(ub + (prow + o) * CONVW + 2 * c2) = yst[o]; }
            if (tile + 1 < tile_end) CONV_DMA(tile + 1, buf ^ 1);
            LAS bf16_t* uS = (LAS bf16_t*)(L + buf * 65536);
            if (t0 == 0) {
                for (int idx = tid; idx < 30 * 64; idx += NTHR) *(LAS u32x4*)(uS + idx * 8) = (u32x4){0u, 0u, 0u, 0u};
                LBAR();
            }
            h16x2 ah[16];
#pragma unroll
            for (int o = 0; o < 16; ++o) ah[o] = bd;
#pragma unroll
            for (int j = 0; j < 46; ++j) { const h16x2 xv = *(const LAS h16x2*)(uS + (th * 16 + j) * CONVW + 2 * c2);
#pragma unroll
                for (int o = 0; o < 16; ++o) { const int k = j - o; if (k >= 0 && k < CONVK) ah[o] = __builtin_elementwise_fma(wv[k], xv, ah[o]); } }
            float a0[16], a1[16];
#pragma unroll
            for (int o = 0; o < 16; ++o) { a0[o] = (float)ah[o][0]; a1[o] = (float)ah[o][1]; }
            float v16[16], v8[8];
#pragma unroll
            for (int o = 0; o < 16; ++o) { const float sv = a0[o] + a1[o], qv = a0[o] * a0[o] + a1[o] * a1[o];
                auto r = __builtin_amdgcn_permlane32_swap(__float_as_uint(sv), __float_as_uint(qv), false, false); v16[o] = __uint_as_float(r[0]) + __uint_as_float(r[1]); }
#pragma unroll
            for (int t = 0; t < 8; ++t) { auto r = __builtin_amdgcn_permlane16_swap(__float_as_uint(v16[t]), __float_as_uint(v16[8 + t]), false, false); v8[t] = __uint_as_float(r[0]) + __uint_as_float(r[1]); }
#define DPP_ADD(v, ctrl) v += __uint_as_float((unsigned)__builtin_amdgcn_update_dpp(0, (int)__float_as_uint(v), ctrl, 0xF, 0xF, true))
#pragma unroll
            for (int t = 0; t < 8; ++t) { DPP_ADD(v8[t], 0xB1); DPP_ADD(v8[t], 0x4E); DPP_ADD(v8[t], 0x141); DPP_ADD(v8[t], 0x140); }
#undef DPP_ADD
            { const int l16 = lane & 15; float sel = v8[0];
#pragma unroll
              for (int t = 1; t < 8; ++t) sel = (l16 == t) ? v8[t] : sel;
              if (l16 < 8) red[((th * 16 + 8 * ((lane >> 4) & 1) + l16) * 2 + (lane >> 5)) * 4 + wq] = sel; }
            LBAR();
#pragma unroll
            for (int o = 0; o < 16; ++o) { const f32x4 s4 = *(const LAS f32x4*)(red + (th * 16 + o) * 8), q4 = *(const LAS f32x4*)(red + (th * 16 + o) * 8 + 4);
                const float mean = ((s4[0] + s4[1]) + (s4[2] + s4[3])) * (1.f / CONVW);
                const float var = fmaxf(((q4[0] + q4[1]) + (q4[2] + q4[3])) * (1.f / CONVW) - mean * mean, 0.f);
                const float rs = __builtin_amdgcn_rsqf(var + EPS);
                const float A0 = rs * lg0, A1 = rs * lg1;
                float y0 = fmaf(a0[o], A0, fmaf(-mean, A0, lb0)), y1 = fmaf(a1[o], A1, fmaf(-mean, A1, lb1));
                y0 *= sigmoidf_(y0); y1 *= sigmoidf_(y1);
                yst[o] = cvt_pk_bf16(y0, y1); }
            prow = rowbase + th * 16;
        }
        if (it) {
#pragma unroll
            for (int o = 0; o < 16; ++o) *(unsigned*)(ub + (prow + o) * CONVW + 2 * c2) = yst[o]; }
#undef CONV_DMA
#undef LBAR
        asm volatile("s_waitcnt vmcnt(0)" ::: "memory");
        __syncthreads();
    }
    if (args.mask & ~(1 << 2)) GRID_BAR();
    }

    if (args.mask & ((1 << 4) | (1 << 11))) {
    {
        const int vcu = (G % 8 == 0) ? (bx % 8) * (G / 8) + bx / 8 : bx;
        if (args.mask & (1 << 4)) for (int uu = vcu; uu < 2 * NBATCH * NH; uu += G) {
            const int bh = uu >> 1, half = uu & 1;
#pragma unroll 1
            for (int i = 0; i < 4; ++i) { const int s = half * 2 + (i >> 1), qb = (i & 1) ? 7 - s : s;
                const int b = bh / NH, h = bh % NH;
                const size_t tok0 = (size_t)b * SEQ + qb * 256;
                att::attn_unit(qkvd + tok0 * 512, Wq_img + (size_t)h * 96 * 256, cstab + tok0 * 32, g_qk_q, Kg + (size_t)bh * SEQ * 96, Vg + (size_t)bh * SEQ * 64,
                               attn + tok0 * 512 + h * 64, 4 * qb + 4, (char*)lds, L, wave, i == 0, i < 3); }
        }
        __syncthreads();
    }
    if (args.mask & ~((1 << 4) | (1 << 11))) GRID_BAR();
    }

    if (args.mask & (1 << 5)) {
    {
        pg8::YSched S; S.Ab = ub; S.Aa = attn; S.Bb = Wt_c; S.Ba = Wt_o; S.lda = 512; S.ldb = 512; S.G = G; S.c = bx; S.nper = (512 + G - 1) / G;
        pg8::EpiY E{pg8::EpiMulGate{gates, 1024, mb}, pg8::EpiMerge{gates, mb, merged}};
        pg8::gemm_phase<pg8::EpiY, pg8::YSched, true>(L, wave, 512, S, E);
    }
    if (args.mask & ~(1 << 5)) GRID_BAR();
    }

    if (args.mask & (1 << 6)) {
    {
        pg8::DenseSched S; S.init(merged, 1024, Wt_out, 1024, NTOK, 1024, G, bx); S.ntk = 16; pg8::EpiResid E{xb, rstd1, x1b};
        pg8::gemm_phase<pg8::EpiResid, pg8::DenseSched, true>(L, wave, 1024, S, E);
    }
    if (args.mask & ~(1 << 6)) GRID_BAR();
    }

    if (args.mask & (1 << 7)) {
    {
        const int lane = lane_id_fresh(), tid = wave * 64 + lane; (void)tid; (void)lane;
        LAS unsigned* lcnt = (LAS unsigned*)(L + MISC_OFF + 256); LAS unsigned* lbase = (LAS unsigned*)(L + MISC_OFF + 512);
        for (int rb = bx; rb < NTOK / 128; rb += G) {
            f32x4 acc[3]; acc[0] = acc[1] = acc[2] = (f32x4){0.f, 0.f, 0.f, 0.f}; float ssq = 0.f;
            const int row = rb * 128 + wave * 16 + (lane & 15);
            const bf16_t* xr = x1b + (size_t)row * DM + 8 * (lane >> 4);
            if (tid < 32) lcnt[tid] = 0u;
#pragma unroll 1
            for (int kh = 0; kh < 2; ++kh) {
                __syncthreads();
#pragma unroll
                for (int i = 0; i < 12; ++i) { const int idx = i * NTHR + tid; ((LAS u32x4*)L)[idx] = ((const u32x4*)(WrB + (size_t)kh * 49152))[idx]; }
                __syncthreads();
#pragma unroll 4
                for (int ks = 0; ks < 16; ++ks) {
                    const u32x4 hw = *(const u32x4*)(xr + kh * 512 + ks * 32);
                    { const float a0 = bf_lo(hw.x), a1 = bf_hi(hw.x), a2 = bf_lo(hw.y), a3 = bf_hi(hw.y), a4 = bf_lo(hw.z), a5 = bf_hi(hw.z), a6 = bf_lo(hw.w), a7 = bf_hi(hw.w);
                      ssq += (a0 * a0 + a1 * a1) + (a2 * a2 + a3 * a3) + (a4 * a4 + a5 * a5) + (a6 * a6 + a7 * a7); }
                    const bf16x8 ah = __builtin_bit_cast(bf16x8, hw);
#pragma unroll
                    for (int cf = 0; cf < 3; ++cf) {
                        const bf16x8 bh = *(const LAS bf16x8*)(L + ((ks * 3 + cf) * 2 + 0) * 1024 + lane * 16), bl = *(const LAS bf16x8*)(L + ((ks * 3 + cf) * 2 + 1) * 1024 + lane * 16);
                        acc[cf] = __builtin_amdgcn_mfma_f32_16x16x32_bf16(ah, bh, acc[cf], 0, 0, 0);
                        acc[cf] = __builtin_amdgcn_mfma_f32_16x16x32_bf16(ah, bl, acc[cf], 0, 0, 0);
                    }
                }
            }
            ssq += __shfl_xor(ssq, 16); ssq += __shfl_xor(ssq, 32);
            const float rs = 1.0f / sqrtf(ssq * (1.f / DM) + EPS);
            LAS float* zs = (LAS float*)(L + 98304) + wave * (16 * 48);
#pragma unroll
            for (int cf = 0; cf < 3; ++cf)
#pragma unroll
                for (int rg = 0; rg < 4; ++rg) zs[(4 * (lane >> 4) + rg) * 48 + 16 * cf + (lane & 15)] = acc[cf][rg];
            LDS_WAIT(); asm volatile("" ::: "memory");
            int e1 = 0, e2 = 0; float wgt1 = 0.f, wgt2 = 0.f; unsigned p1 = 0, p2 = 0;
            if (lane < 16) {
                const LAS float* zr = zs + lane * 48;
                float zg[4]; int g = 0; float zm;
#pragma unroll
                for (int i = 0; i < 4; ++i) zg[i] = zr[i] * rs + b_gr[i];
                zm = zg[0];
#pragma unroll
                for (int i = 1; i < 4; ++i) if (zg[i] > zm) { zm = zg[i]; g = i; }
                float den = 0.f;
#pragma unroll
                for (int i = 0; i < 4; ++i) den += __expf(zg[i] - zm);
                const float gp = 1.0f / den;
                float v1 = -3.0e38f, v2 = -3.0e38f; int i1 = 0, i2 = 0;
#pragma unroll
                for (int j = 0; j < 8; ++j) { const float z = zr[4 + 8 * g + j] * rs + b_er[8 * g + j];
                    if (z > v1) { v2 = v1; i2 = i1; v1 = z; i1 = j; } else if (z > v2) { v2 = z; i2 = j; } }
                const float w1 = 1.0f / (1.0f + __expf(v2 - v1));
                e1 = 8 * g + i1; e2 = 8 * g + i2; wgt1 = gp * w1; wgt2 = gp * (1.0f - w1);
                p1 = atomicAdd((unsigned*)(lds + MISC_OFF + 256) + e1, 1u); p2 = atomicAdd((unsigned*)(lds + MISC_OFF + 256) + e2, 1u);
                rstd2[row] = rs;
            }
            __syncthreads();
            if (tid < 32) lbase[tid] = atomicAdd(gcnt + tid, lcnt[tid]);
            __syncthreads();
            if (lane < 16) {
                const size_t i1 = (size_t)e1 * CAP + lbase[e1] + p1, i2 = (size_t)e2 * CAP + lbase[e2] + p2;
                ltok[i1] = row * 2; lw[i1] = wgt1; ltok[i2] = row * 2 + 1; lw[i2] = wgt2;
            }
            __syncthreads();
        }
    }
    if (args.mask & ~(1 << 7)) GRID_BAR();
    }

    LAS int* tstart = (LAS int*)(L + MISC_OFF + 1024); LAS int* ecnt = (LAS int*)(L + MISC_OFF + 1280); LAS int* tile_e = (LAS int*)(L + MISC_OFF + 1536);
    if (args.mask & (1 << 8)) {
        const int tid = wave * 64 + lane_id_fresh();
        if (tid == 0) { int acc = 0; for (int e = 0; e < 32; ++e) { const int c = (int)__hip_atomic_load(gcnt + e, __ATOMIC_RELAXED, __HIP_MEMORY_SCOPE_AGENT); ecnt[e] = c; tstart[e] = acc;
                const int nt_ = (c + 255) >> 8; for (int q = 0; q < nt_; ++q) tile_e[acc + q] = e; acc += nt_; } tstart[32] = acc; }
        __syncthreads();
    }
    if (args.mask & (1 << 8)) {
    {
        const int ntile = __builtin_amdgcn_readfirstlane(tstart[32]);
        pg8::MoeSched S; S.x1b = x1b; S.mid = mid; S.Wgu = Wt_gu; S.Wd = Wt_d; S.ltok = ltok; S.tcnt = ctl + CW_TCNT; S.tstart = tstart; S.cnt = ecnt; S.tile_e = tile_e; S.T = ntile; S.G = G; S.c = (G % 8 == 0) ? (bx % 8) * (G / 8) + bx / 8 : bx;
        pg8::EpiMoe E{pg8::EpiGU{ltok, lw, rstd2, mid}, pg8::EpiDown{ltok, ybuf}};
        pg8::gemm_phase_moe<pg8::EpiMoe, pg8::MoeSched>(L, wave, S, E);
    }
    if (args.mask & ~(1 << 8)) GRID_BAR();
    }

    if (args.mask & (1 << 10)) {
    {
        const int tid = wave * 64 + lane_id_fresh();
        for (size_t i = (size_t)bx * NTHR + tid; i < (size_t)NTOK * DM / 8; i += (size_t)G * NTHR) {
            f32x4 a0, a1, b0, b1; unpack8_fp8(*(const u32x2*)(ybuf + i * 8), 1.f / Y_SC, a0, a1); unpack8_fp8(*(const u32x2*)(ybuf + (size_t)NTOK * DM + i * 8), 1.f / Y_SC, b0, b1);
            f32x4 x0, x1_; load8(x1b + i * 8, x0, x1_); f32x4* o = (f32x4*)(out + i * 8); o[0] = x0 + a0 + b0; o[1] = x1_ + a1 + b1;
        }
    }
    }
}

extern "C" void kernel_launch(void* const* d_in, const int* in_sizes, int n_in, void* d_out, int out_size, void* d_ws, size_t ws_size, hipStream_t stream) {
    static int grid = 0;
    if (grid == 0) {
        if (n_in != 26 || out_size != NTOK * DM || ws_size < WS_END) { fprintf(stderr, "kernel_launch: unexpected shapes: n_in %d out %d ws %zu\n", n_in, out_size, ws_size); grid = -1; return; }
        int dev = 0, cus = 0;
        if (hipGetDevice(&dev) != hipSuccess || hipDeviceGetAttribute(&cus, hipDeviceAttributeMultiprocessorCount, dev) != hipSuccess) { grid = -1; return; }
        if (hipFuncSetAttribute((const void*)mk_fwd, hipFuncAttributeMaxDynamicSharedMemorySize, LDS_BYTES) != hipSuccess) { fprintf(stderr, "kernel_launch: hipFuncSetAttribute failed\n"); grid = -1; return; }
        int per_cu = 0;
        if (hipOccupancyMaxActiveBlocksPerMultiprocessor(&per_cu, (const void*)mk_fwd, NTHR, LDS_BYTES) != hipSuccess || per_cu < 1) fprintf(stderr, "kernel_launch: occupancy query reports %d\n", per_cu);
        (void)hipGetLastError();
        grid = cus;
    }
    if (grid < 0) return;
    (void)hipMemsetAsync((char*)d_ws + WS_CTL, 0, CTL_ZERO_BYTES, stream);
    Args a{};
    for (int i = 0; i < 26; ++i) a.in[i] = d_in[i];
    a.out = (float*)d_out; a.ws = (unsigned char*)d_ws;
#if USE_CG
    void* kargs[] = {&a};
    hipError_t le = hipLaunchCooperativeKernel((const void*)mk_fwd, dim3(grid), dim3(NTHR), kargs, LDS_BYTES, stream);
    if (le != hipSuccess) fprintf(stderr, "kernel_launch: cooperative launch failed: %s\n", hipGetErrorString(le));
#else
    a.mask = 0xfff; a.pad = 0;
    hipLaunchKernelGGL(mk_fwd, dim3(grid), dim3(NTHR), LDS_BYTES, stream, a);
#ifdef EXTRA_MASK
    { const int ms[] = EXTRA_MASK; for (int q = 0; q < (int)(sizeof(ms) / sizeof(int)); ++q) { a.mask = ms[q]; (void)hipMemsetAsync((char*)d_ws + WS_CTL, 0, 32768, stream); hipLaunchKernelGGL(mk_fwd, dim3(grid), dim3(NTHR), LDS_BYTES, stream, a); } }
#endif
#endif
}
```
